# Optimizing an MI355X kernel written in HIP

```python
import math
import jax, jax.numpy as jnp
from jax import lax
import numpy as np

D_MODEL = 1024
BATCH = 8
SEQ = 2048
DEPTH = 4
DEC_BATCH = 128
DEC_SEQ = 4
PAST_LEN = 16384
PAGE_SIZE = 128

DN_HEADS = 4
DN_DK = 128
DN_DV = 128
DN_KEY_WIDTH = DN_HEADS * DN_DK
DN_VAL_WIDTH = DN_HEADS * DN_DV
DN_QKV = 2 * DN_KEY_WIDTH + DN_VAL_WIDTH
DN_CONV = 4
DN_CHUNK = 64
LRU_WIDTH = D_MODEL // 2
LRU_BLOCKS = 4
LRU_BW = LRU_WIDTH // LRU_BLOCKS
LRU_CONV = 4
LRU_C = 8.0
D_FF = 3 * D_MODEL
FFN_CONV = 3
NORM_EPS = 1e-6
SPLIT_SIZES = (DN_QKV, DN_VAL_WIDTH, DN_HEADS, DN_HEADS, LRU_WIDTH, LRU_WIDTH, D_MODEL, D_MODEL)
IN_COLS = sum(SPLIT_SIZES)
SPLIT_POINTS = [int(v) for v in np.cumsum(SPLIT_SIZES)[:-1]]

kernel_name = "hybrid_gdn_rglru_convffn_step"


def rmsnorm(x, w):
    xf = x.astype(jnp.float32)
    y = xf * lax.rsqrt(jnp.mean(xf * xf, axis=-1, keepdims=True) + NORM_EPS)
    return (y * w.astype(jnp.float32)).astype(x.dtype)


def l2norm(x):
    return x * lax.rsqrt(jnp.sum(x * x, axis=-1, keepdims=True) + NORM_EPS)


def causal_dwconv(x, buf, w):
    width = w.shape[0]
    seq = x.shape[1]
    xp = jnp.concatenate([buf.astype(x.dtype), x], axis=1)
    y = xp[:, 0:seq] * w[0]
    for j in range(1, width):
        y = y + xp[:, j:j + seq] * w[j]
    return y, xp[:, xp.shape[1] - (width - 1):]


def gated_delta_rule(q, k, v, g, beta, s0):
    bsz, seq, nh, dk = q.shape
    dv = v.shape[-1]
    c = min(DN_CHUNK, seq)
    n = -(-seq // c)
    pad = n * c - seq

    def blocks(t):
        t = jnp.pad(t, [(0, 0), (0, pad)] + [(0, 0)] * (t.ndim - 2))
        t = t.reshape((bsz, n, c) + t.shape[2:])
        return jnp.swapaxes(t, 2, 3)

    q, k, v, g, beta = (blocks(t) for t in (q * (dk ** -0.5), k, v, g, beta))
    gc = jnp.cumsum(g, axis=-1)
    idx = jnp.arange(c)
    incl = idx[:, None] >= idx[None, :]
    strict = idx[:, None] > idx[None, :]
    diff = gc[..., :, None] - gc[..., None, :]
    decay = jnp.where(incl, jnp.exp(jnp.where(incl, diff, 0.0)), 0.0)
    kb = k * beta[..., None]
    vb = v * beta[..., None]
    m = jnp.where(strict, jnp.einsum('bnhid,bnhjd->bnhij', kb, k) * decay, 0.0)
    eye = jnp.eye(c, dtype=m.dtype)
    rhs = jnp.concatenate([vb, kb * jnp.exp(gc)[..., None]], axis=-1)
    sol = lax.linalg.triangular_solve(m + eye, rhs, left_side=True, lower=True, unit_diagonal=True)
    u, w = sol[..., :dv], sol[..., dv:]
    attn = jnp.einsum('bnhid,bnhjd->bnhij', q, k) * decay
    qg = q * jnp.exp(gc)[..., None]
    kd = k * jnp.exp(gc[..., -1:] - gc)[..., None]
    glast = jnp.exp(gc[..., -1])

    def step(s, xs):
        u_i, w_i, qg_i, attn_i, kd_i, gl_i = xs
        v_new = u_i - jnp.einsum('bhck,bhkv->bhcv', w_i, s)
        o_i = jnp.einsum('bhck,bhkv->bhcv', qg_i, s) + jnp.einsum('bhij,bhjv->bhiv', attn_i, v_new)
        s = s * gl_i[..., None, None] + jnp.einsum('bhck,bhcv->bhkv', kd_i, v_new)
        return s, o_i

    xs = tuple(jnp.moveaxis(t, 1, 0) for t in (u, w, qg, attn, kd, glast))
    s_final, o = lax.scan(step, s0, xs)
    o = jnp.transpose(o, (1, 0, 3, 2, 4)).reshape(bsz, n * c, nh, dv)[:, :seq]
    return o, s_final


def _linear_combine(left, right):
    a_l, b_l = left
    a_r, b_r = right
    return a_l * a_r, a_r * b_l + b_r


def rg_lru(xb, h0, wa, ba, wx, bx, lam, start_pos):
    f32 = jnp.float32
    bsz, seq, width = xb.shape
    xf = xb.astype(f32)
    xblk = xf.reshape(bsz, seq, LRU_BLOCKS, LRU_BW)
    r = jax.nn.sigmoid(jnp.einsum('blnc,ncd->blnd', xblk, wa.astype(f32)).reshape(bsz, seq, width) + ba.astype(f32))
    i = jax.nn.sigmoid(jnp.einsum('blnc,ncd->blnd', xblk, wx.astype(f32)).reshape(bsz, seq, width) + bx.astype(f32))
    log_a = -LRU_C * r * jax.nn.softplus(-lam.astype(f32))
    a = jnp.exp(log_a)
    mult = jnp.sqrt(-jnp.expm1(2.0 * log_a))
    pos = start_pos + jnp.arange(seq)
    mult = jnp.where((pos == 0)[None, :, None], 1.0, mult)
    b = mult * i * xf
    b = jnp.concatenate([b[:, :1] + a[:, :1] * h0.astype(f32)[:, None], b[:, 1:]], axis=1)
    _, h = lax.associative_scan(_linear_combine, (a, b), axis=1)
    return h, h[:, -1]


def hybrid_layer(x, dn_buf, dn_s, lru_buf, lru_h, ffn_buf, lw, start_pos):
    (norm1_w, w_in, dn_conv_w, dn_A_log, dn_dt_bias, dn_norm_w, lru_conv_w, lru_conv_b,
     lru_wa, lru_ba, lru_wx, lru_bx, lru_lambda, w_branch_a, w_branch_b, w_o,
     norm2_w, ffn_w_in, ffn_conv_w, ffn_w_down) = lw
    f32 = jnp.float32
    bsz, seq, _ = x.shape
    h = rmsnorm(x, norm1_w)
    proj = jnp.einsum('bld,dc->blc', h, w_in)
    qkv, z, a_in, b_in, lru_x, lru_y, gate_a, gate_b = jnp.split(proj, SPLIT_POINTS, axis=-1)

    qkv, new_dn_buf = causal_dwconv(qkv, dn_buf, dn_conv_w)
    qkv = jax.nn.silu(qkv).astype(f32)
    q, k, v = jnp.split(qkv, [DN_KEY_WIDTH, 2 * DN_KEY_WIDTH], axis=-1)
    q = l2norm(q.reshape(bsz, seq, DN_HEADS, DN_DK))
    k = l2norm(k.reshape(bsz, seq, DN_HEADS, DN_DK))
    v = v.reshape(bsz, seq, DN_HEADS, DN_DV)
    beta = jax.nn.sigmoid(b_in.astype(f32))
    g = -jnp.exp(dn_A_log.astype(f32)) * jax.nn.softplus(a_in.astype(f32) + dn_dt_bias.astype(f32))
    o, new_s = gated_delta_rule(q, k, v, g, beta, dn_s.astype(f32))
    zf = z.astype(f32).reshape(bsz, seq, DN_HEADS, DN_DV)
    o = rmsnorm(o, dn_norm_w) * jax.nn.silu(zf)
    o_a = o.reshape(bsz, seq, DN_VAL_WIDTH).astype(x.dtype)

    xc, new_lru_buf = causal_dwconv(lru_x, lru_buf, lru_conv_w)
    xc = xc + lru_conv_b
    hseq, new_h = rg_lru(xc, lru_h, lru_wa, lru_ba, lru_wx, lru_bx, lru_lambda, start_pos)
    o_b = (hseq * jax.nn.gelu(lru_y.astype(f32), approximate=True)).astype(x.dtype)

    br_a = jnp.einsum('blc,cd->bld', o_a, w_branch_a)
    br_b = jnp.einsum('blc,cd->bld', o_b, w_branch_b)
    merged = jax.nn.sigmoid(gate_a) * br_a + jax.nn.sigmoid(gate_b) * br_b
    x = x + jnp.einsum('bld,de->ble', merged, w_o)

    h2 = rmsnorm(x, norm2_w)
    gu = jnp.einsum('bld,df->blf', h2, ffn_w_in)
    gate, up = jnp.split(gu, [D_FF], axis=-1)
    gate, new_ffn_buf = causal_dwconv(gate, ffn_buf, ffn_conv_w)
    x = x + jnp.einsum('blf,fd->bld', jax.nn.gelu(gate, approximate=True) * up, ffn_w_down)
    return (x, new_dn_buf, new_s.astype(dn_s.dtype), new_lru_buf, new_h.astype(lru_h.dtype), new_ffn_buf)


def run_trunk(x, dn_buf, dn_s, lru_buf, lru_h, ffn_buf, weights, final_norm_w, start_pos):
    outs = ([], [], [], [], [])
    for l in range(DEPTH):
        lw = tuple(w[l] for w in weights)
        x, *new = hybrid_layer(x, dn_buf[l], dn_s[l], lru_buf[l], lru_h[l], ffn_buf[l], lw, start_pos)
        for lst, s in zip(outs, new):
            lst.append(s)
    y = rmsnorm(x, final_norm_w)
    return (y, jnp.stack(outs[0]), jnp.stack(outs[1]), jnp.stack(outs[2]), jnp.stack(outs[3]), jnp.stack(outs[4]))


def setup_inputs(seed: int = 0) -> dict:
    key = jax.random.key(seed)
    ks = jax.random.split(key, 32)
    f32 = jnp.float32

    def nrm(k, shape, scale):
        return jax.random.normal(k, shape, f32) * scale

    dt = jnp.exp(jax.random.uniform(ks[11], (DEPTH, DN_HEADS), f32, math.log(1e-3), math.log(1e-1)))
    u = jax.random.uniform(ks[19], (DEPTH, LRU_WIDTH), f32, 0.9, 0.999)
    s = u ** (1.0 / LRU_C)
    return {
        'x_prompt': nrm(ks[0], (BATCH, SEQ, D_MODEL), 1.0),
        'x_sample': nrm(ks[1], (DEC_BATCH, DEC_SEQ, D_MODEL), 1.0),
        'state_dn_conv': nrm(ks[2], (DEPTH, DEC_BATCH, DN_CONV - 1, DN_QKV), 1.0),
        'state_dn': nrm(ks[3], (DEPTH, DEC_BATCH, DN_HEADS, DN_DK, DN_DV), 0.3),
        'state_lru_conv': nrm(ks[4], (DEPTH, DEC_BATCH, LRU_CONV - 1, LRU_WIDTH), 1.0),
        'state_lru': nrm(ks[5], (DEPTH, DEC_BATCH, LRU_WIDTH), 1.0),
        'state_ffn_conv': nrm(ks[6], (DEPTH, DEC_BATCH, FFN_CONV - 1, D_FF), 1.0),
        'norm1_w': 1.0 + nrm(ks[7], (DEPTH, D_MODEL), 0.02),
        'w_in': nrm(ks[8], (DEPTH, D_MODEL, IN_COLS), D_MODEL ** -0.5),
        'dn_conv_w': nrm(ks[9], (DEPTH, DN_CONV, DN_QKV), DN_CONV ** -0.5),
        'dn_A_log': jnp.log(jax.random.uniform(ks[10], (DEPTH, DN_HEADS), f32, 1.0, 16.0)),
        'dn_dt_bias': dt + jnp.log(-jnp.expm1(-dt)),
        'dn_norm_w': 1.0 + nrm(ks[12], (DEPTH, DN_DV), 0.02),
        'lru_conv_w': nrm(ks[13], (DEPTH, LRU_CONV, LRU_WIDTH), LRU_CONV ** -0.5),
        'lru_conv_b': nrm(ks[14], (DEPTH, LRU_WIDTH), 0.02),
        'lru_wa': nrm(ks[15], (DEPTH, LRU_BLOCKS, LRU_BW, LRU_BW), LRU_BW ** -0.5),
        'lru_ba': nrm(ks[16], (DEPTH, LRU_WIDTH), 0.02),
        'lru_wx': nrm(ks[17], (DEPTH, LRU_BLOCKS, LRU_BW, LRU_BW), LRU_BW ** -0.5),
        'lru_bx': nrm(ks[18], (DEPTH, LRU_WIDTH), 0.02),
        'lru_lambda': jnp.log(s) - jnp.log1p(-s),
        'w_branch_a': nrm(ks[20], (DEPTH, DN_VAL_WIDTH, D_MODEL), DN_VAL_WIDTH ** -0.5),
        'w_branch_b': nrm(ks[21], (DEPTH, LRU_WIDTH, D_MODEL), LRU_WIDTH ** -0.5),
        'w_o': nrm(ks[22], (DEPTH, D_MODEL, D_MODEL), D_MODEL ** -0.5),
        'norm2_w': 1.0 + nrm(ks[23], (DEPTH, D_MODEL), 0.02),
        'ffn_w_in': nrm(ks[24], (DEPTH, D_MODEL, 2 * D_FF), D_MODEL ** -0.5),
        'ffn_conv_w': nrm(ks[25], (DEPTH, FFN_CONV, D_FF), FFN_CONV ** -0.5),
        'ffn_w_down': nrm(ks[26], (DEPTH, D_FF, D_MODEL), D_FF ** -0.5),
        'final_norm_w': 1.0 + nrm(ks[27], (D_MODEL,), 0.02),
    }


def reference(x_prompt, x_sample, state_dn_conv, state_dn, state_lru_conv, state_lru, state_ffn_conv,
              norm1_w, w_in, dn_conv_w, dn_A_log, dn_dt_bias, dn_norm_w, lru_conv_w, lru_conv_b,
              lru_wa, lru_ba, lru_wx, lru_bx, lru_lambda, w_branch_a, w_branch_b, w_o,
              norm2_w, ffn_w_in, ffn_conv_w, ffn_w_down, final_norm_w):
    weights = (norm1_w, w_in, dn_conv_w, dn_A_log, dn_dt_bias, dn_norm_w, lru_conv_w, lru_conv_b,
               lru_wa, lru_ba, lru_wx, lru_bx, lru_lambda, w_branch_a, w_branch_b, w_o,
               norm2_w, ffn_w_in, ffn_conv_w, ffn_w_down)
    lead = (DEPTH, BATCH)
    z_dn_conv = jnp.zeros(lead + state_dn_conv.shape[2:], state_dn_conv.dtype)
    z_dn = jnp.zeros(lead + state_dn.shape[2:], state_dn.dtype)
    z_lru_conv = jnp.zeros(lead + state_lru_conv.shape[2:], state_lru_conv.dtype)
    z_lru = jnp.zeros(lead + state_lru.shape[2:], state_lru.dtype)
    z_ffn_conv = jnp.zeros(lead + state_ffn_conv.shape[2:], state_ffn_conv.dtype)
    y_prompt, p_dn_conv, p_dn, p_lru_conv, p_lru, p_ffn_conv = run_trunk(
        x_prompt, z_dn_conv, z_dn, z_lru_conv, z_lru, z_ffn_conv, weights, final_norm_w, 0)
    y_sample, s_dn_conv, s_dn, s_lru_conv, s_lru, s_ffn_conv = run_trunk(
        x_sample, state_dn_conv, state_dn, state_lru_conv, state_lru, state_ffn_conv, weights, final_norm_w, PAST_LEN)
    return (y_prompt, y_sample, p_dn_conv, p_dn, p_lru_conv, p_lru, p_ffn_conv,
            s_dn_conv, s_dn, s_lru_conv, s_lru, s_ffn_conv)
```

```cpp
#include <hip/hip_runtime.h>
#include <hip/hip_cooperative_groups.h>
#include <cstdio>
#include <cstdint>
namespace cg = cooperative_groups;

#define LAS __attribute__((address_space(3)))
#define DEV __device__ __forceinline__
typedef unsigned short bf16_t;
typedef short bf16x8 __attribute__((ext_vector_type(8)));
typedef float f32x4 __attribute__((ext_vector_type(4)));
typedef float f32x2 __attribute__((ext_vector_type(2)));
typedef unsigned u32x4 __attribute__((ext_vector_type(4)));
typedef unsigned u32x2 __attribute__((ext_vector_type(2)));

constexpr int D = 1024, NBATCH = 8, SEQ = 2048, DEPTH = 4, SBATCH = 128, SSEQ = 4;
constexpr int MP = NBATCH * SEQ, MS = SBATCH * SSEQ, M = MP + MS;
constexpr int NPROJ = 5376;
constexpr int DFF = 3072;
constexpr int NSLOT = 16;
constexpr int C_QKV = 0, C_Z = 1536, C_LX = 2048, C_LY = 2560, C_GA = 3072, C_GB = 4096, C_AIN = 5120, C_BIN = 5124;
constexpr size_t O_YP = 0, O_YS = 16777216, O_PDC = 17301504, O_PDN = 17448960, O_PLC = 19546112, O_PL = 19595264, O_PFC = 19611648,
                 O_SDC = 19808256, O_SDN = 22167552, O_SLC = 55721984, O_SL = 56508416, O_SFC = 56770560, O_END = 59916288;
constexpr size_t MiB = 1u << 20;
constexpr size_t WS_SSQ = 1 * MiB, WS_GB = 3 * MiB, WS_WB = 4 * MiB, WB_STRIDE = 34 * MiB;
constexpr size_t WS_XF = 72 * MiB, WS_XB = 138 * MiB, WS_PROJ = 171 * MiB, WS_QKVN = 345 * MiB, WS_WP = 347 * MiB, WS_QGP = 363 * MiB, WS_KDP = 379 * MiB, WS_UTP = 395 * MiB, WS_ATP = 411 * MiB;
constexpr size_t WS_CSA = 419 * MiB, WS_CSH = 420 * MiB, WS_GL = 420 * MiB + 786432, WS_OAB = 421 * MiB;
constexpr size_t WS_MERGED = 347 * MiB, WS_HB = 171 * MiB, WS_Z = 454 * MiB, WS_END = 460 * MiB;
constexpr size_t WO_WIN = 0, WO_WAB = 11 * MiB, WO_WO = 13 * MiB, WO_WFF = 15 * MiB, WO_WDN = 27 * MiB, WO_LWA = 33 * MiB, WO_LWX = 33 * MiB + 131072;
constexpr int LDS_BYTES = 147456;

DEV float bf2f(unsigned short b) { return __uint_as_float(((unsigned)b) << 16); }
DEV unsigned f2bf(float f) { unsigned u = __float_as_uint(f); return (u + 0x7fffu + ((u >> 16) & 1u)) >> 16; }
DEV unsigned pk2(float lo, float hi) { return f2bf(lo) | (f2bf(hi) << 16); }
DEV float sigm(float x) { return 1.f / (1.f + __expf(-x)); }
DEV float siluf_(float x) { return x / (1.f + __expf(-x)); }
DEV float gelu_t(float x) { const float u = 1.5957691216f * (x + 0.044715f * x * x * x); return x / (1.f + __expf(-u)); }
DEV float neg_expm1(float x) {
    const float pz = x * (1.f + x * (0.5f + x * (0.16666667f + x * (0.041666668f + x * (0.0083333338f + x * 0.0013888889f)))));
    return x > -0.3f ? -pz : 1.f - __expf(x);
}
DEV float softplus_(float x) { return fmaxf(x, 0.f) + log1pf(__expf(-fabsf(x))); }
DEV float wave_sum(float v) {
#pragma unroll
    for (int o = 1; o < 64; o <<= 1) v += __shfl_xor(v, o);
    return v;
}
DEV void unpack8(const u32x4 w, float (&f)[8]) {
    f[0] = __uint_as_float(w.x << 16); f[1] = __uint_as_float(w.x & 0xffff0000u); f[2] = __uint_as_float(w.y << 16); f[3] = __uint_as_float(w.y & 0xffff0000u);
    f[4] = __uint_as_float(w.z << 16); f[5] = __uint_as_float(w.z & 0xffff0000u); f[6] = __uint_as_float(w.w << 16); f[7] = __uint_as_float(w.w & 0xffff0000u);
}
DEV u32x4 pack8(const float (&f)[8]) { u32x4 w; w.x = pk2(f[0], f[1]); w.y = pk2(f[2], f[3]); w.z = pk2(f[4], f[5]); w.w = pk2(f[6], f[7]); return w; }

struct Params { const float* in[28]; float* out; unsigned char* ws; };
enum { I_XP = 0, I_XS, I_SDC, I_SDN, I_SLC, I_SL, I_SFC, I_N1, I_WIN, I_DCW, I_ALOG, I_DTB, I_DNW, I_LCW, I_LCB, I_LWA, I_LBA, I_LWX, I_LBX, I_LAM, I_WBA, I_WBB, I_WO, I_N2, I_WFF, I_FCW, I_WDN, I_FNW };

namespace pg8 {
constexpr int BM = 256, BK = 64, HALF = 128, HTB = HALF * BK * 2, STAGE_BYTES = 8 * HTB, NXCD = 8, WGM = 8;
__host__ __device__ __forceinline__ int lds_byte(int r, int c) { const int st = (r >> 4) * 2 + (c >> 5), rr = r & 15, cc = c & 31, ob = rr * 64 + cc * 2; return st * 1024 + (ob ^ (((ob >> 9) & 1) << 5)); }
__host__ __device__ __forceinline__ void stage_rc(int b, int& R, int& C) { const int st = b / 1024, sb = b % 1024, swz = sb ^ (((sb >> 9) & 1) << 5); R = (st >> 1) * 16 + swz / 64; C = (st & 1) * 32 + (swz % 64) / 2; }
__host__ __device__ __forceinline__ int perm32(int rho) { const int n = rho >> 4, i = rho & 15; return 8 * (i >> 2) + 4 * n + (i & 3); }
struct Unit { int pm, pn, kh; };
struct Gemm { const bf16_t* A; const bf16_t* Bt; int lda, ldb, K; };
struct StaticOrder {
    int nM, nN, nwg, G, c;
    __device__ void init(int M_, int N_, int G_, int c_) { nM = M_ / BM; nN = N_ / BM; nwg = nM * nN; G = G_; c = c_; }
    __device__ bool next(int i, Unit& u) const {
        const long L = (long)i * G + c; if (L >= nwg) return false;
        int wgid = (int)L; { const int q = nwg / NXCD, r = nwg % NXCD, xcd = wgid % NXCD, off = wgid / NXCD; wgid = (xcd < r ? xcd * (q + 1) : r * (q + 1) + (xcd - r) * q) + off; }
        const int nig = WGM * nN, gid = wgid / nig, fm = gid * WGM, gsz = (nM - fm) < WGM ? (nM - fm) : WGM;
        u.pm = fm + ((wgid % nig) % gsz); u.pn = (wgid % nig) / gsz; u.kh = 0; return true;
    }
};
struct TwoHalfOrder : StaticOrder {
    __device__ bool next(int i, Unit& u) const { if (!StaticOrder::next(i >> 1, u)) return false; u.kh = i & 1; return true; }
};
struct SampleSplitOrder {
    int G, c;
    __device__ bool next(int i, Unit& u) const { const int L = i * G + c; if (L >= 24) return false; const int rem = L % 12; u.pm = MP / BM + L / 12; u.pn = rem / 3; u.kh = rem % 3; return true; }
};
DEV unsigned cvt_pk_bf16(float lo, float hi) { unsigned r; asm volatile("v_cvt_pk_bf16_f32 %0, %1, %2" : "=v"(r) : "v"(lo), "v"(hi)); return r; }

template <class Epi, class Sched, int MODE>
DEV void gemm_phase(LAS unsigned char* lds, const Gemm g, const Sched& S, const Epi& E) {
    int tid = threadIdx.x; asm volatile("" : "+v"(tid));
    const int wid = __builtin_amdgcn_readfirstlane(tid >> 6), lane = tid & 63, wr = wid >> 2, wc = wid & 3, fr = lane & 15, fq = lane >> 4;
    const int K = g.K, nt = K / BK;
    unsigned voffA[2], voffB[2];
#pragma unroll
    for (int i = 0; i < 2; ++i) { int R, C; stage_rc(tid * 16 + i * 8192, R, C); const int Rb = Epi::PERM ? ((R & ~31) + perm32(R & 31)) : R;
        voffA[i] = (unsigned)(R * g.lda + C) * 2u; voffB[i] = (unsigned)(Rb * g.ldb + C) * 2u; }
    const size_t kstep = (size_t)(BK * 2);
    const size_t hstepA = (size_t)HALF * g.lda * 2, hstepB = (size_t)HALF * g.ldb * 2;
    const size_t tstepA = 2 * hstepA, tstepB = 2 * hstepB;
    const unsigned ldsw = (unsigned)wid * 1024u;
    const int aoff = lds_byte(wr * 64 + fr, fq * 8), boff = lds_byte(wc * 32 + fr, fq * 8);
#define PG8_SA(b, h) (((b) * 2 + (h)) * HTB)
#define PG8_SB(b, h) ((4 + (b) * 2 + (h)) * HTB)
#define PG8_STAGE(bufoff, gbase, voff) do { _Pragma("unroll") for (int _i = 0; _i < 2; ++_i) \
        __builtin_amdgcn_global_load_lds((const unsigned*)((const char*)(gbase) + (voff)[_i]), (LAS unsigned*)(lds + (bufoff) + ldsw + _i * 8192), 16, 0, 0); } while (0)
#define PG8_LDA(dst, b, h) do { _Pragma("unroll") for (int m = 0; m < 4; ++m) _Pragma("unroll") for (int k = 0; k < 2; ++k) dst[m][k] = *(const LAS bf16x8*)(lds + PG8_SA(b, h) + aoff + m * 2048 + k * 1024); } while (0)
#define PG8_LDB(dst, b, h) do { _Pragma("unroll") for (int n = 0; n < 2; ++n) _Pragma("unroll") for (int k = 0; k < 2; ++k) dst[n][k] = *(const LAS bf16x8*)(lds + PG8_SB(b, h) + boff + n * 2048 + k * 1024); } while (0)
#define PG8_MMA(ai, bj, At, Bt) do { __builtin_amdgcn_s_setprio(1); _Pragma("unroll") for (int m = 0; m < 4; ++m) _Pragma("unroll") for (int n = 0; n < 2; ++n) _Pragma("unroll") for (int k = 0; k < 2; ++k) \
        acc[ai][bj][m][n] = __builtin_amdgcn_mfma_f32_16x16x32_bf16(Bt[n][k], At[m][k], acc[ai][bj][m][n], 0, 0, 0); __builtin_amdgcn_s_setprio(0); } while (0)
#define PG8_WAIT_V(n) asm volatile("s_waitcnt vmcnt(" #n ")" ::: "memory")
#define PG8_WAIT_L(n) asm volatile("s_waitcnt lgkmcnt(" #n ")" ::: "memory")
#define PG8_BAR __builtin_amdgcn_s_barrier()
#define PG8_SCHED __builtin_amdgcn_sched_barrier(0)
    Unit cur, nxt; int ui = 0;
    if (!S.next(0, cur)) return;
    f32x4 acc[2][2][4][2];
#pragma unroll
    for (int a = 0; a < 2; ++a)
#pragma unroll
        for (int b = 0; b < 2; ++b)
#pragma unroll
            for (int m = 0; m < 4; ++m)
#pragma unroll
                for (int n = 0; n < 2; ++n) acc[a][b][m][n] = (f32x4){0.f, 0.f, 0.f, 0.f};
    bf16x8 At[4][2], B0[2][2], B1[2][2];
    const size_t khstep = MODE ? (size_t)K * 2 : 0;
    const char* cA = (const char*)g.A + (size_t)cur.pm * tstepA + cur.kh * khstep; const char* cB = (const char*)g.Bt + (size_t)cur.pn * tstepB + cur.kh * khstep;
    PG8_STAGE(PG8_SB(0, 0), cB, voffB); PG8_STAGE(PG8_SB(0, 1), cB + hstepB, voffB); PG8_STAGE(PG8_SA(0, 0), cA, voffA); PG8_STAGE(PG8_SA(0, 1), cA + hstepA, voffA);
    if (wr == 1) PG8_BAR;
    PG8_WAIT_V(2); PG8_BAR;
    PG8_STAGE(PG8_SB(1, 0), cB + kstep, voffB); PG8_STAGE(PG8_SA(1, 0), cA + kstep, voffA); PG8_STAGE(PG8_SB(1, 1), cB + hstepB + kstep, voffB);
    PG8_WAIT_V(6); PG8_BAR;
    for (;;) {
        const bool has_next = S.next(ui + 1, nxt);
        const char* nA = has_next ? (const char*)g.A + (size_t)nxt.pm * tstepA + nxt.kh * khstep : cA; const char* nB = has_next ? (const char*)g.Bt + (size_t)nxt.pn * tstepB + nxt.kh * khstep : cB;
        for (int t = 0; t < nt; t += 2) {
            const bool last = (t == nt - 2);
            const char* a1 = cA + (size_t)(t + 1) * kstep;
            const char* a2 = last ? nA : cA + (size_t)(t + 2) * kstep; const char* b2 = last ? nB : cB + (size_t)(t + 2) * kstep;
            const char* a3 = a2 + kstep; const char* b3 = b2 + kstep;
            PG8_LDB(B0, 0, 0); PG8_LDB(B1, 0, 1); PG8_SCHED; PG8_LDA(At, 0, 0); PG8_STAGE(PG8_SA(1, 1), a1 + hstepA, voffA);
            PG8_WAIT_V(8); PG8_WAIT_L(0); PG8_BAR; PG8_MMA(0, 0, At, B0); PG8_MMA(0, 1, At, B1); PG8_BAR; PG8_SCHED;
            PG8_LDA(At, 0, 1); PG8_STAGE(PG8_SB(0, 0), b2, voffB); PG8_STAGE(PG8_SB(0, 1), b2 + hstepB, voffB); PG8_STAGE(PG8_SA(0, 0), a2, voffA);
            PG8_WAIT_V(8); PG8_WAIT_L(0); PG8_BAR; PG8_MMA(1, 0, At, B0); PG8_MMA(1, 1, At, B1); PG8_BAR; PG8_SCHED;
            PG8_LDB(B0, 1, 0); PG8_LDB(B1, 1, 1); PG8_SCHED; PG8_LDA(At, 1, 0); PG8_STAGE(PG8_SA(0, 1), a2 + hstepA, voffA);
            PG8_WAIT_V(8); PG8_WAIT_L(0); PG8_BAR; PG8_MMA(0, 0, At, B0); PG8_MMA(0, 1, At, B1); PG8_BAR; PG8_SCHED;
            PG8_LDA(At, 1, 1); PG8_STAGE(PG8_SB(1, 0), b3, voffB); PG8_STAGE(PG8_SB(1, 1), b3 + hstepB, voffB); PG8_STAGE(PG8_SA(1, 0), a3, voffA);
            PG8_WAIT_V(8); PG8_WAIT_L(0); PG8_BAR; PG8_MMA(1, 0, At, B0); PG8_MMA(1, 1, At, B1); PG8_BAR; PG8_SCHED;
        }
        if (wr == 0) PG8_BAR;
        E(acc, cur, wr, wc, fr, fq);
        if (!has_next) break;
        if (!(MODE == 1 && cur.kh == 0)) {
#pragma unroll
        for (int a = 0; a < 2; ++a)
#pragma unroll
            for (int b = 0; b < 2; ++b)
#pragma unroll
                for (int m = 0; m < 4; ++m)
#pragma unroll
                    for (int n = 0; n < 2; ++n) acc[a][b][m][n] = (f32x4){0.f, 0.f, 0.f, 0.f};
        }
        cur = nxt; cA = nA; cB = nB; ++ui;
        if (wr == 1) PG8_BAR;
    }
    PG8_WAIT_V(0);
    PG8_BAR;
#undef PG8_SA
#undef PG8_SB
#undef PG8_STAGE
#undef PG8_LDA
#undef PG8_LDB
#undef PG8_MMA
#undef PG8_WAIT_V
#undef PG8_WAIT_L
#undef PG8_BAR
#undef PG8_SCHED
}

struct EpiScaleBf16 {
    static constexpr bool PERM = true;
    bf16_t* O; int ldc; const float* ssq;
    DEV void operator()(const f32x4 (&acc)[2][2][4][2], const Unit& u, int wr, int wc, int fr, int fq) const {
        const int row0 = u.pm * BM + wr * 64 + fr, col0 = u.pn * BM + wc * 32 + 8 * fq;
#pragma unroll
        for (int ai = 0; ai < 2; ++ai) {
            f32x4 sv[4][4];
#pragma unroll
            for (int i = 0; i < 4; ++i)
#pragma unroll
                for (int k = 0; k < 4; ++k) sv[i][k] = *(const f32x4*)(ssq + (size_t)(row0 + ai * HALF + i * 16) * NSLOT + 4 * k);
#pragma unroll
            for (int m = 0; m < 4; ++m) {
                const int row = row0 + ai * HALF + m * 16;
                const f32x4 s4 = (sv[m][0] + sv[m][1]) + (sv[m][2] + sv[m][3]);
                const float s = (s4[0] + s4[1]) + (s4[2] + s4[3]);
                const float rs = rsqrtf(s * (1.f / 1024.f) + 1e-6f);
                bf16_t* rowp = O + (size_t)row * ldc + col0;
#pragma unroll
                for (int bj = 0; bj < 2; ++bj) { const f32x4 v0 = acc[ai][bj][m][0] * rs, v1 = acc[ai][bj][m][1] * rs;
                    u32x4 w; w.x = cvt_pk_bf16(v0[0], v0[1]); w.y = cvt_pk_bf16(v0[2], v0[3]); w.z = cvt_pk_bf16(v1[0], v1[1]); w.w = cvt_pk_bf16(v1[2], v1[3]);
                    *(u32x4*)(rowp + bj * HALF) = w; }
            }
        }
    }
};
struct EpiMerge {
    static constexpr bool PERM = true;
    bf16_t* O; const bf16_t* P;
    DEV void mid(f32x4 (&acc)[2][2][4][2], const Unit& u, int wr, int wc, int fr, int fq) const {
        const int row0 = u.pm * BM + wr * 64 + fr, col0 = u.pn * BM + wc * 32 + 8 * fq;
#pragma unroll
        for (int ai = 0; ai < 2; ++ai)
#pragma unroll
            for (int m = 0; m < 4; ++m) {
                const bf16_t* rowp = P + (size_t)(row0 + ai * HALF + m * 16) * NPROJ + col0;
#pragma unroll
                for (int bj = 0; bj < 2; ++bj) {
                    float ga[8], gb[8]; unpack8(*(const u32x4*)(rowp + C_GA + bj * HALF), ga); unpack8(*(const u32x4*)(rowp + C_GB + bj * HALF), gb);
#pragma unroll
                    for (int e = 0; e < 8; ++e) { const float ratio = (1.f + __expf(-gb[e])) / (1.f + __expf(-ga[e])); acc[ai][bj][m][e >> 2][e & 3] *= ratio; }
                    asm volatile("" ::: "memory");
                }
            }
    }
    DEV void operator()(f32x4 (&acc)[2][2][4][2], const Unit& u, int wr, int wc, int fr, int fq) const {
        if (u.kh == 0) { mid(acc, u, wr, wc, fr, fq); return; }
        const int row0 = u.pm * BM + wr * 64 + fr, col0 = u.pn * BM + wc * 32 + 8 * fq;
#pragma unroll
        for (int ai = 0; ai < 2; ++ai)
#pragma unroll
            for (int m = 0; m < 4; ++m) {
                const int row = row0 + ai * HALF + m * 16;
                const bf16_t* rowp = P + (size_t)row * NPROJ + col0;
#pragma unroll
                for (int bj = 0; bj < 2; ++bj) {
                    float gb[8]; unpack8(*(const u32x4*)(rowp + C_GB + bj * HALF), gb);
                    float o[8];
#pragma unroll
                    for (int e = 0; e < 8; ++e) o[e] = acc[ai][bj][m][e >> 2][e & 3] / (1.f + __expf(-gb[e]));
                    u32x4 w; w.x = cvt_pk_bf16(o[0], o[1]); w.y = cvt_pk_bf16(o[2], o[3]); w.z = cvt_pk_bf16(o[4], o[5]); w.w = cvt_pk_bf16(o[6], o[7]);
                    *(u32x4*)(O + (size_t)row * D + col0 + bj * HALF) = w;
                }
            }
    }
};
struct EpiResid {
    static constexpr bool PERM = false;
    bf16_t* XB; float* ssq;
    DEV void operator()(const f32x4 (&acc)[2][2][4][2], const Unit& u, int wr, int wc, int fr, int fq) const {
        const int row0 = u.pm * BM + wr * 64 + fr, col0 = u.pn * BM + wc * 32 + 4 * fq;
#pragma unroll
        for (int ai = 0; ai < 2; ++ai) {
            u32x2 xin[4][2][2];
#pragma unroll
            for (int m = 0; m < 4; ++m)
#pragma unroll
                for (int bj = 0; bj < 2; ++bj)
#pragma unroll
                    for (int n = 0; n < 2; ++n) xin[m][bj][n] = *(const u32x2*)(XB + (size_t)(row0 + ai * HALF + m * 16) * D + col0 + bj * HALF + n * 16);
#pragma unroll
            for (int m = 0; m < 4; ++m) {
                const int row = row0 + ai * HALF + m * 16;
                bf16_t* br = XB + (size_t)row * D + col0;
                float ss = 0.f;
#pragma unroll
                for (int bj = 0; bj < 2; ++bj)
#pragma unroll
                    for (int n = 0; n < 2; ++n) {
                        const u32x2 xi = xin[m][bj][n];
                        const float x0 = __uint_as_float(xi.x << 16) + acc[ai][bj][m][n][0], x1 = __uint_as_float(xi.x & 0xffff0000u) + acc[ai][bj][m][n][1];
                        const float x2 = __uint_as_float(xi.y << 16) + acc[ai][bj][m][n][2], x3 = __uint_as_float(xi.y & 0xffff0000u) + acc[ai][bj][m][n][3];
                        u32x2 w; w.x = cvt_pk_bf16(x0, x1); w.y = cvt_pk_bf16(x2, x3); *(u32x2*)(br + bj * HALF + n * 16) = w;
                        const float r0 = __uint_as_float(w.x << 16), r1 = __uint_as_float(w.x & 0xffff0000u), r2 = __uint_as_float(w.y << 16), r3 = __uint_as_float(w.y & 0xffff0000u);
                        ss += (r0 * r0 + r1 * r1) + (r2 * r2 + r3 * r3);
                    }
                ss += __shfl_xor(ss, 16); ss += __shfl_xor(ss, 32);
                if (fq == 0) ssq[(size_t)row * NSLOT + u.pn * 4 + wc] = ss;
            }
        }
    }
};
struct EpiPartial {
    static constexpr bool PERM = false;
    float* Z;
    DEV void operator()(const f32x4 (&acc)[2][2][4][2], const Unit& u, int wr, int wc, int fr, int fq) const {
        const int row0 = u.pm * BM - MP + wr * 64 + fr, col0 = u.pn * BM + wc * 32 + 4 * fq;
        float* zb = Z + (size_t)u.kh * MS * D;
#pragma unroll
        for (int ai = 0; ai < 2; ++ai)
#pragma unroll
            for (int m = 0; m < 4; ++m)
#pragma unroll
                for (int bj = 0; bj < 2; ++bj)
#pragma unroll
                    for (int n = 0; n < 2; ++n) *(f32x4*)(zb + (size_t)(row0 + ai * HALF + m * 16) * D + col0 + bj * HALF + n * 16) = acc[ai][bj][m][n];
    }
};
}

#define XB_TMO      128
#define XB_XCNT(j)  (256  + 64 * (j))
#define XB_XSUB(j)  (1280 + 64 * (j))
#define XB_XGEN(j)  (2304 + 64 * (j))
#define XB_TOP      3328
#define XB_TOPGEN   3392
#define XCD_BAR_WORDS 3456
#define XB_SPIN_CAP (1u << 20)
DEV unsigned xb_ld(unsigned* p)              { return __hip_atomic_load(p, __ATOMIC_RELAXED, __HIP_MEMORY_SCOPE_AGENT); }
DEV unsigned xb_add(unsigned* p, unsigned v) { return __hip_atomic_fetch_add(p, v, __ATOMIC_RELAXED, __HIP_MEMORY_SCOPE_AGENT); }
DEV unsigned xb_xcc_id() { return (unsigned)__builtin_amdgcn_s_getreg((3 << 11) | 20) & 0xFu; }
#define XB_SPIN(cond, bar) do { unsigned _sp = 0; while (cond) { __builtin_amdgcn_s_sleep(1); \
    if ((++_sp & 255u) == 0u) { if (xb_ld(&(bar)[XB_TMO])) break; if (_sp > XB_SPIN_CAP) { atomicAdd(&(bar)[XB_TMO], 1u); break; } } } } while (0)
struct XcdBarrier { unsigned* bar; unsigned x; volatile LAS unsigned* st; };
DEV XcdBarrier xcd_barrier_post(unsigned* bar, volatile LAS unsigned* st) {
    XcdBarrier b; b.bar = bar; b.x = xb_xcc_id(); b.st = st;
    if (threadIdx.x == 0) (void)xb_add(&bar[XB_XCNT(b.x)], 1u);
    return b;
}
DEV void xcd_barrier_complete(unsigned* bar, unsigned x, unsigned& nloc, unsigned& nx) {
    const unsigned G = gridDim.x * gridDim.y * gridDim.z;
    unsigned sum, cnt, mine, sp = 0u;
    for (;;) {
        sum = 0u; cnt = 0u; mine = 0u;
#pragma unroll
        for (unsigned j = 0; j < 16; ++j) { const unsigned c = xb_ld(&bar[XB_XCNT(j)]); sum += c; cnt += (c > 0u) ? 1u : 0u; mine = (j == x) ? c : mine; }
        if (sum == G) break;
        __builtin_amdgcn_s_sleep(1);
        if ((++sp & 255u) == 0u) { if (xb_ld(&bar[XB_TMO])) break; if (sp > XB_SPIN_CAP) { atomicAdd(&bar[XB_TMO], 1u); break; } }
    }
    nloc = mine > 0u ? mine : 1u; nx = cnt > 0u ? cnt : 1u;
}
DEV void xcd_barrier(const XcdBarrier& b) {
    asm volatile("s_waitcnt vmcnt(0)" ::: "memory");
    __syncthreads();
    if (threadIdx.x == 0) {
        unsigned* bar = b.bar;
        __builtin_amdgcn_s_waitcnt(0);
        unsigned nloc = b.st[0], nx = b.st[1];
        if (nloc == 0u) { xcd_barrier_complete(bar, b.x, nloc, nx); b.st[0] = nloc; b.st[1] = nx; }
        const unsigned old = xb_add(&bar[XB_XSUB(b.x)], 1u);
        const unsigned gen = old / nloc;
        if (old + 1u == (gen + 1u) * nloc) {
            __builtin_amdgcn_fence(__ATOMIC_RELEASE, "agent");
            asm volatile("s_waitcnt vmcnt(0)" ::: "memory");
            const unsigned og = xb_add(&bar[XB_TOP], 1u);
            const unsigned tg = og / nx;
            if (og + 1u == (tg + 1u) * nx) xb_add(&bar[XB_TOPGEN], 1u);
            else XB_SPIN(xb_ld(&bar[XB_TOPGEN]) == tg, bar);
            __builtin_amdgcn_fence(__ATOMIC_ACQUIRE, "agent");
            xb_add(&bar[XB_XGEN(b.x)], 1u);
            asm volatile("s_waitcnt vmcnt(0)" ::: "memory");
        } else {
            XB_SPIN(xb_ld(&bar[XB_XGEN(b.x)]) == gen, bar);
            __builtin_amdgcn_fence(__ATOMIC_ACQUIRE, "agent");
            asm volatile("s_waitcnt vmcnt(0)" ::: "memory");
        }
    }
    __syncthreads();
}

struct Ctx {
    const Params* p;
    unsigned char* ws;
    float* SSQ; float* GB; float* XF; bf16_t* XB; bf16_t* PROJ; bf16_t* QKVN; bf16_t* OAB; bf16_t* MERGED; bf16_t* HB;
    bf16_t *WP, *QGP, *KDP, *UTP, *ATP; float *CSA, *CSH, *GL;
    int tid, lane, wave, G, bid;
};
DEV unsigned char* wbuf(const Ctx& c, int l) { return c.ws + WS_WB + (size_t)(l & 1) * WB_STRIDE; }
DEV Ctx mk(const Params& prm) {
    Ctx c; c.p = &prm;
    size_t zoff = 0; asm volatile("" : "+s"(zoff)); unsigned char* w = prm.ws + zoff; c.ws = w;
    c.SSQ = (float*)(w + WS_SSQ); c.GB = (float*)(w + WS_GB); c.XF = (float*)(w + WS_XF); c.XB = (bf16_t*)(w + WS_XB);
    c.PROJ = (bf16_t*)(w + WS_PROJ); c.QKVN = (bf16_t*)(w + WS_QKVN);
    c.WP = (bf16_t*)(w + WS_WP); c.QGP = (bf16_t*)(w + WS_QGP); c.KDP = (bf16_t*)(w + WS_KDP); c.UTP = (bf16_t*)(w + WS_UTP); c.ATP = (bf16_t*)(w + WS_ATP);
    c.CSA = (float*)(w + WS_CSA); c.CSH = (float*)(w + WS_CSH); c.GL = (float*)(w + WS_GL);
    c.OAB = (bf16_t*)(w + WS_OAB); c.MERGED = (bf16_t*)(w + WS_MERGED); c.HB = (bf16_t*)(w + WS_HB);
    int tid = threadIdx.x; asm volatile("" : "+v"(tid));
    c.tid = tid; c.lane = tid & 63; c.wave = __builtin_amdgcn_readfirstlane(tid >> 6); c.G = gridDim.x; c.bid = blockIdx.x;
    return c;
}

DEV void tr_item(const float* W, int Nsrc, const float* kscale, bf16_t* WT, int ldk, int k0, int n0, int mode, LAS float* scr, int lane) {
    const int n = n0 + (lane & 31);
    int src = n;
    if (mode == 1) src = (n < 2048) ? n : (n < 5120 ? n + 8 : (n < 5128 ? n - 5120 + 2048 : -1));
#pragma unroll 8
    for (int i = 0; i < 32; ++i) { const int kk = 2 * i + (lane >> 5); float v = 0.f;
        if (src >= 0) v = W[(size_t)(k0 + kk) * Nsrc + src];
        if (kscale) v *= kscale[k0 + kk];
        scr[kk * 33 + (lane & 31)] = v; }
    asm volatile("s_waitcnt lgkmcnt(0)" ::: "memory");
    const int cch = lane & 7;
#pragma unroll
    for (int j = 0; j < 4; ++j) { const int nn = (lane >> 3) + 8 * j; const LAS float* s = scr + (8 * cch) * 33 + nn;
        u32x4 o; o.x = pk2(s[0 * 33], s[1 * 33]); o.y = pk2(s[2 * 33], s[3 * 33]); o.z = pk2(s[4 * 33], s[5 * 33]); o.w = pk2(s[6 * 33], s[7 * 33]);
        *(u32x4*)(WT + (size_t)(n0 + nn) * ldk + k0 + 8 * cch) = o; }
    asm volatile("s_waitcnt lgkmcnt(0)" ::: "memory");
}
DEV void convert_layer(const Ctx& c, int l, int w, int nw, LAS unsigned char* lds) {
    LAS float* scr = (LAS float*)(lds + c.wave * 16384);
    unsigned char* wb = wbuf(c, l);
    const Params& p = *c.p;
    constexpr int I_IN = 16 * (NPROJ / 32), I_AB = 8 * 32, I_O = 16 * 32, I_FF = 16 * (2 * DFF / 32), I_DN = (DFF / 64) * 32, I_L = 2 * 4;
    constexpr int TOT = I_IN + 2 * I_AB + I_O + I_FF + I_DN + 8 * I_L;
    for (int it = w; it < TOT; it += nw) {
        int r = it;
        if (r < I_IN) { const int nb = NPROJ / 32; tr_item(p.in[I_WIN] + (size_t)l * D * 5128, 5128, p.in[I_N1] + l * D, (bf16_t*)(wb + WO_WIN), D, 64 * (r / nb), 32 * (r % nb), 1, scr, c.lane); continue; } r -= I_IN;
        if (r < I_AB) { tr_item(p.in[I_WBA] + (size_t)l * 512 * D, D, nullptr, (bf16_t*)(wb + WO_WAB), D, 64 * (r / 32), 32 * (r % 32), 0, scr, c.lane); continue; } r -= I_AB;
        if (r < I_AB) { tr_item(p.in[I_WBB] + (size_t)l * 512 * D, D, nullptr, (bf16_t*)(wb + WO_WAB) + 512, D, 64 * (r / 32), 32 * (r % 32), 0, scr, c.lane); continue; } r -= I_AB;
        if (r < I_O) { tr_item(p.in[I_WO] + (size_t)l * D * D, D, nullptr, (bf16_t*)(wb + WO_WO), D, 64 * (r / 32), 32 * (r % 32), 0, scr, c.lane); continue; } r -= I_O;
        if (r < I_FF) { const int nb = 2 * DFF / 32; tr_item(p.in[I_WFF] + (size_t)l * D * 2 * DFF, 2 * DFF, p.in[I_N2] + l * D, (bf16_t*)(wb + WO_WFF), D, 64 * (r / nb), 32 * (r % nb), 0, scr, c.lane); continue; } r -= I_FF;
        if (r < I_DN) { tr_item(p.in[I_WDN] + (size_t)l * DFF * D, D, nullptr, (bf16_t*)(wb + WO_WDN), DFF, 64 * (r / 32), 32 * (r % 32), 0, scr, c.lane); continue; } r -= I_DN;
        { const int mat = r / I_L, rr = r % I_L, blk = mat & 3, which = mat >> 2;
          const float* W = (which ? p.in[I_LWX] : p.in[I_LWA]) + (size_t)(l * 4 + blk) * 16384;
          bf16_t* WT = (bf16_t*)(wb + (which ? WO_LWX : WO_LWA)) + blk * 16384;
          tr_item(W, 128, nullptr, WT, 128, 64 * (rr / 4), 32 * (rr % 4), 0, scr, c.lane); }
    }
}

DEV void x_prologue(const Ctx& c) {
    const int gw = c.bid * 8 + c.wave, NGW = c.G * 8;
    for (int row = gw; row < M; row += NGW) {
        const float* src = row < MP ? c.p->in[I_XP] + (size_t)row * D : c.p->in[I_XS] + (size_t)(row - MP) * D;
        float ss = 0.f;
#pragma unroll
        for (int j = 0; j < 4; ++j) { const f32x4 v = *(const f32x4*)(src + j * 256 + c.lane * 4);
            u32x2 w; w.x = pk2(v[0], v[1]); w.y = pk2(v[2], v[3]); *(u32x2*)(c.XB + (size_t)row * D + j * 256 + c.lane * 4) = w;
            const float r0 = __uint_as_float(w.x << 16), r1 = __uint_as_float(w.x & 0xffff0000u), r2 = __uint_as_float(w.y << 16), r3 = __uint_as_float(w.y & 0xffff0000u);
            ss += (r0 * r0 + r1 * r1) + (r2 * r2 + r3 * r3); }
        ss = wave_sum(ss);
        if (c.lane < NSLOT) c.SSQ[(size_t)row * NSLOT + c.lane] = (c.lane == 0) ? ss : 0.f;
    }
}

DEV void dn_prep_rows(const Ctx& c, int l) {
    const Params& p = *c.p;
    const int gw = c.bid * 8 + c.wave, NGW = c.G * 8, lane = c.lane;
    const float* cw = p.in[I_DCW] + (size_t)l * 4 * 1536;
    for (int row = MP + gw; row < M; row += NGW) {
        const int sb = (row - MP) >> 2, pos = (row - MP) & 3; const float* hist = p.in[I_SDC] + (size_t)(l * SBATCH + sb) * 3 * 1536;
#pragma unroll
        for (int ch = 0; ch < 3; ++ch) {
            const int col = ch * 512 + lane * 8;
            float a[8];
#pragma unroll
            for (int e = 0; e < 8; ++e) a[e] = 0.f;
            float own[8];
#pragma unroll
            for (int j = 0; j < 4; ++j) {
                float v[8];
                const int sp = pos - 3 + j;
                if (sp >= 0) unpack8(*(const u32x4*)(c.PROJ + (size_t)(row - 3 + j) * NPROJ + C_QKV + col), v);
                else { const f32x4 h0 = *(const f32x4*)(hist + (size_t)(pos + j) * 1536 + col), h1 = *(const f32x4*)(hist + (size_t)(pos + j) * 1536 + col + 4);
                    v[0] = h0[0]; v[1] = h0[1]; v[2] = h0[2]; v[3] = h0[3]; v[4] = h1[0]; v[5] = h1[1]; v[6] = h1[2]; v[7] = h1[3]; }
                const f32x4 w0 = *(const f32x4*)(cw + j * 1536 + col), w1 = *(const f32x4*)(cw + j * 1536 + col + 4);
#pragma unroll
                for (int e = 0; e < 4; ++e) { a[e] += v[e] * w0[e]; a[e + 4] += v[e + 4] * w1[e]; }
                if (j == 3) {
#pragma unroll
                    for (int e = 0; e < 8; ++e) own[e] = v[e]; }
            }
            float ss = 0.f;
#pragma unroll
            for (int e = 0; e < 8; ++e) { a[e] = siluf_(a[e]); ss += a[e] * a[e]; }
            if (ch < 2) {
                ss += __shfl_xor(ss, 1); ss += __shfl_xor(ss, 2); ss += __shfl_xor(ss, 4); ss += __shfl_xor(ss, 8);
                const float sc = rsqrtf(ss + 1e-6f) * (ch == 0 ? 0.08838834764831845f : 1.f);
#pragma unroll
                for (int e = 0; e < 8; ++e) a[e] *= sc;
            }
            *(u32x4*)(c.QKVN + (size_t)(row - MP) * 1536 + col) = pack8(a);
            if (pos >= 1) { float* dst = p.out + O_SDC + ((size_t)(l * SBATCH + sb) * 3 + (pos - 1)) * 1536 + col;
                *(f32x4*)dst = (f32x4){own[0], own[1], own[2], own[3]}; *(f32x4*)(dst + 4) = (f32x4){own[4], own[5], own[6], own[7]}; }
        }
        if (lane < 4) {
            const float ain = bf2f(c.PROJ[(size_t)row * NPROJ + C_AIN + lane]), bin = bf2f(c.PROJ[(size_t)row * NPROJ + C_BIN + lane]);
            const float g = -__expf(p.in[I_ALOG][l * 4 + lane]) * softplus_(ain + p.in[I_DTB][l * 4 + lane]);
            c.GB[(size_t)(row - MP) * 8 + lane] = g; c.GB[(size_t)(row - MP) * 8 + 4 + lane] = sigm(bin);
        }
    }
}

DEV int slot_of(int idx) { return (idx & ~31) | (((idx >> 2) & 3) << 3) | (((idx >> 4) & 1) << 2) | (idx & 3); }
template <int I> struct SolveRow {
    template <int NC> static DEV void run(float (&X)[64], const LAS float* Mv, const f32x4 (&cur)[NC]) {
        constexpr int NV = (I + 3) / 4;
        constexpr int NLATE = NV > 8 ? NV - 8 : 0;
        constexpr int NN = ((I + 1 + 3) / 4) > 8 ? 8 : ((I + 1 + 3) / 4);
        f32x4 late[NLATE > 0 ? NLATE : 1];
#pragma unroll
        for (int k = 0; k < NLATE; ++k) late[k] = *(const LAS f32x4*)(Mv + I * 68 + 4 * (8 + k));
        f32x4 nxt[NN];
        if constexpr (I + 1 < 64) {
#pragma unroll
            for (int k = 0; k < NN; ++k) nxt[k] = *(const LAS f32x4*)(Mv + (I + 1) * 68 + 4 * k);
        }
        __builtin_amdgcn_sched_barrier(0);
        float a0 = X[I], a1 = 0.f, a2 = 0.f, a3 = 0.f;
#pragma unroll
        for (int k = 0; k < NV; ++k) {
            const f32x4 mv = k < 8 ? cur[k < NC ? k : 0] : late[k >= 8 ? k - 8 : 0];
            a0 -= mv[0] * X[4 * k];
            if (4 * k + 1 < I) a1 -= mv[1] * X[4 * k + 1];
            if (4 * k + 2 < I) a2 -= mv[2] * X[4 * k + 2];
            if (4 * k + 3 < I) a3 -= mv[3] * X[4 * k + 3];
        }
        X[I] = (a0 + a1) + (a2 + a3);
        __builtin_amdgcn_sched_barrier(0);
        if constexpr (I + 1 < 64) SolveRow<I + 1>::run(X, Mv, nxt);
    }
};
DEV void dn_chunk_prep(const Ctx& c, int l, int item, LAS unsigned char* lds) {
    const Params& p = *c.p;
    const int b = item >> 7, n = (item >> 2) & 31, h = item & 3, row0 = b * SEQ + n * 64, tid = c.tid, lane = c.lane, wave = c.wave;
    LAS float* Mm = (LAS float*)lds;
    LAS float* gcs = (LAS float*)(lds + 17408);
    LAS bf16_t* qn = (LAS bf16_t*)(lds + 18432);
    LAS bf16_t* kn = qn + 64 * 136;
    LAS bf16_t* vv = kn + 64 * 136;
    LAS float* bet = gcs + 64; LAS float* egs = gcs + 128; LAS float* bke = gcs + 192;
    bf16_t* QGP = c.QGP + (size_t)item * 8192; bf16_t* WP = c.WP + (size_t)item * 8192; bf16_t* KDP = c.KDP + (size_t)item * 8192;
    bf16_t* UTP = c.UTP + (size_t)item * 8192; bf16_t* ATP = c.ATP + (size_t)item * 4096;
    LAS float* cwl = (LAS float*)(lds + 70656);
    if (tid < 384) {
        const int ch = tid >> 7, cc = tid & 127;
#pragma unroll
        for (int j = 0; j < 4; ++j) cwl[j * 384 + tid] = p.in[I_DCW][(size_t)(l * 4 + j) * 1536 + ch * 512 + h * 128 + cc];
    }
    if (tid < 64) {
        const int row = row0 + tid;
        const float ain = bf2f(c.PROJ[(size_t)row * NPROJ + C_AIN + h]), bin = bf2f(c.PROJ[(size_t)row * NPROJ + C_BIN + h]);
        float g = -__expf(p.in[I_ALOG][l * 4 + h]) * softplus_(ain + p.in[I_DTB][l * 4 + h]);
        const float be = sigm(bin);
#pragma unroll
        for (int o = 1; o < 64; o <<= 1) { const float t = __shfl_up(g, o); if (lane >= o) g += t; }
        const float e = __expf(g);
        gcs[tid] = g; bet[tid] = be; egs[tid] = e; bke[tid] = be * e;
    }
    __syncthreads();
    {
        const int r = tid >> 3, sub = tid & 7, row = row0 + r;
        const float eg_r = egs[r];
#pragma unroll 1
        for (int ch = 0; ch < 3; ++ch) {
            float a[2][8]; float ss = 0.f;
#pragma unroll
            for (int gi = 0; gi < 2; ++gi) {
                const int col8 = (sub + 8 * gi) * 8, gcol = ch * 512 + h * 128 + col8;
                const LAS float* cw = cwl + ch * 128 + col8;
#pragma unroll
                for (int e = 0; e < 8; ++e) a[gi][e] = 0.f;
#pragma unroll
                for (int j = 0; j < 4; ++j) {
                    float v[8];
                    if (n > 0 || r - 3 + j >= 0) unpack8(*(const u32x4*)(c.PROJ + (size_t)(row - 3 + j) * NPROJ + C_QKV + gcol), v);
                    else {
#pragma unroll
                        for (int e = 0; e < 8; ++e) v[e] = 0.f; }
                    const f32x4 w0 = *(const LAS f32x4*)(cw + j * 384), w1 = *(const LAS f32x4*)(cw + j * 384 + 4);
#pragma unroll
                    for (int e = 0; e < 4; ++e) { a[gi][e] += v[e] * w0[e]; a[gi][e + 4] += v[e + 4] * w1[e]; }
                    if (j == 3 && n == 31 && r >= 61) { float* dst = p.out + O_PDC + ((size_t)(l * NBATCH + b) * 3 + (r - 61)) * 1536 + gcol;
                        *(f32x4*)dst = (f32x4){v[0], v[1], v[2], v[3]}; *(f32x4*)(dst + 4) = (f32x4){v[4], v[5], v[6], v[7]}; }
                }
#pragma unroll
                for (int e = 0; e < 8; ++e) { a[gi][e] = siluf_(a[gi][e]); ss += a[gi][e] * a[gi][e]; }
            }
            if (ch < 2) {
                ss += __shfl_xor(ss, 1); ss += __shfl_xor(ss, 2); ss += __shfl_xor(ss, 4);
                const float sc = rsqrtf(ss + 1e-6f) * (ch == 0 ? 0.08838834764831845f : 1.f);
#pragma unroll
                for (int gi = 0; gi < 2; ++gi)
#pragma unroll
                    for (int e = 0; e < 8; ++e) a[gi][e] *= sc;
            }
            LAS bf16_t* tile = qn + ch * (64 * 136);
#pragma unroll
            for (int gi = 0; gi < 2; ++gi) {
                const int col8 = (sub + 8 * gi) * 8;
                *(LAS u32x4*)(tile + r * 136 + col8) = pack8(a[gi]);
                if (ch == 0) {
                    const int grp = sub + 8 * gi, s = grp >> 2, aa = (grp >> 1) & 1, hh = grp & 1;
                    u32x2 w0, w1; w0.x = pk2(a[gi][0] * eg_r, a[gi][1] * eg_r); w0.y = pk2(a[gi][2] * eg_r, a[gi][3] * eg_r);
                    w1.x = pk2(a[gi][4] * eg_r, a[gi][5] * eg_r); w1.y = pk2(a[gi][6] * eg_r, a[gi][7] * eg_r);
                    *(u32x2*)(QGP + r * 128 + 32 * s + 16 * hh + 4 * aa) = w0; *(u32x2*)(QGP + r * 128 + 32 * s + 16 * hh + 8 + 4 * aa) = w1;
                }
            }
        }
    }
    __syncthreads();
    {
        const int mi = wave & 3, which = wave >> 2, fr = lane & 15, q = lane >> 4;
        const LAS bf16_t* At = which ? qn : kn;
        bf16x8 af[4];
#pragma unroll
        for (int s = 0; s < 4; ++s) af[s] = *(const LAS bf16x8*)(At + (16 * mi + fr) * 136 + 32 * s + 8 * q);
#pragma unroll
        for (int nj = 0; nj < 4; ++nj) {
            f32x4 acc = {0.f, 0.f, 0.f, 0.f};
            if (nj <= mi) {
#pragma unroll
                for (int s = 0; s < 4; ++s) { const bf16x8 bfr = *(const LAS bf16x8*)(kn + (16 * nj + fr) * 136 + 32 * s + 8 * q);
                    acc = __builtin_amdgcn_mfma_f32_16x16x32_bf16(af[s], bfr, acc, 0, 0, 0); }
            }
            const int j = 16 * nj + fr; const float gj = gcs[j];
#pragma unroll
            for (int r = 0; r < 4; ++r) {
                const int i = 16 * mi + 4 * q + r;
                if (which == 0) { if (nj <= mi) Mm[i * 68 + j] = (i > j) ? bet[i] * acc[r] * __expf(gcs[i] - gj) : 0.f; }
                else { const float v = (i >= j) ? acc[r] * __expf(gcs[i] - gj) : 0.f; ATP[i * 64 + slot_of(j)] = (bf16_t)f2bf(v); }
            }
        }
    }
    __syncthreads();
    if (wave < 4) {
        const int isK = wave >> 1, col = 64 * (wave & 1) + lane;
        const LAS bf16_t* src = isK ? kn : vv; const LAS float* mul = isK ? bke : bet;
        float X[64];
#pragma unroll
        for (int i = 0; i < 64; ++i) X[i] = bf2f(src[i * 136 + col]);
        {   int zl0 = 0; asm volatile("" : "+v"(zl0)); const LAS float* mulv = mul + zl0;
#pragma unroll
            for (int i4 = 0; i4 < 16; ++i4) { const f32x4 mm = *(const LAS f32x4*)(mulv + 4 * i4); X[4 * i4] *= mm[0]; X[4 * i4 + 1] *= mm[1]; X[4 * i4 + 2] *= mm[2]; X[4 * i4 + 3] *= mm[3]; } }
        int zl = 0; asm volatile("" : "+v"(zl));
        const LAS float* Mv = Mm + zl;
        { f32x4 cur1[1]; cur1[0] = *(const LAS f32x4*)(Mv + 68); SolveRow<1>::run(X, Mv, cur1); }
        if (!isK) {
#pragma unroll
            for (int t8 = 0; t8 < 8; ++t8) { u32x4 w; w.x = pk2(X[8 * t8], X[8 * t8 + 1]); w.y = pk2(X[8 * t8 + 2], X[8 * t8 + 3]); w.z = pk2(X[8 * t8 + 4], X[8 * t8 + 5]); w.w = pk2(X[8 * t8 + 6], X[8 * t8 + 7]);
                *(u32x4*)(UTP + col * 64 + 8 * t8) = w; }
        } else {
            const int sl = slot_of(col);
#pragma unroll
            for (int t = 0; t < 64; ++t) WP[t * 128 + sl] = (bf16_t)f2bf(X[t]);
        }
    } else {
        const int tt = tid - 256, dk = tt >> 1, s = tt & 1;
        const float gl = gcs[63];
#pragma unroll
        for (int qq = 0; qq < 4; ++qq) {
            float v[8];
#pragma unroll
            for (int j = 0; j < 8; ++j) { const int t = 32 * s + 16 * (j >> 2) + 4 * qq + (j & 3); v[j] = bf2f(kn[t * 136 + dk]) * __expf(gl - gcs[t]); }
            *(u32x4*)(KDP + dk * 64 + 32 * s + 8 * qq) = pack8(v);
        }
        if (tt == 0) c.GL[item] = __expf(gl);
    }
    __syncthreads();
}

DEV void dn_chunk_scan(const Ctx& c, int l, int b, int h, LAS unsigned char* lds) {
    const Params& p = *c.p;
    const int tid = c.tid, lane = c.lane, wave = c.wave, fr = lane & 15, q = lane >> 4, dvc = 16 * wave + fr;
    LAS unsigned char* wl = lds;
    LAS unsigned char* ql = lds + 17408;
    LAS unsigned char* kl = lds + 34816;
    LAS unsigned char* al = lds + 53248;
    LAS float* obuf = (LAS float*)(lds + 62464);
    unsigned soff[7], doff[7];
#pragma unroll
    for (int k = 0; k < 7; ++k) {
        const int pc = tid + 512 * k;
        if (k < 2) { soff[k] = pc * 16; doff[k] = (pc >> 4) * 272 + (pc & 15) * 16; }
        else if (k < 4) { const int pp = pc - 1024; soff[k] = pp * 16; doff[k] = 17408 + (pp >> 4) * 272 + (pp & 15) * 16; }
        else if (k < 6) { const int pp = pc - 2048; soff[k] = pp * 16; doff[k] = 34816 + (pp >> 3) * 144 + (pp & 7) * 16; }
        else { const int pp = pc - 3072; soff[k] = pp * 16; doff[k] = 53248 + (pp >> 3) * 144 + (pp & 7) * 16; }
    }
    const int it0 = (b * 32) * 4 + h;
    u32x4 pf[7];
#define DN_LOAD(itm) do { const size_t io = (size_t)(itm) * 16384; \
        pf[0] = *(const u32x4*)((const char*)c.WP + io + soff[0]); pf[1] = *(const u32x4*)((const char*)c.WP + io + soff[1]); \
        pf[2] = *(const u32x4*)((const char*)c.QGP + io + soff[2]); pf[3] = *(const u32x4*)((const char*)c.QGP + io + soff[3]); \
        pf[4] = *(const u32x4*)((const char*)c.KDP + io + soff[4]); pf[5] = *(const u32x4*)((const char*)c.KDP + io + soff[5]); \
        pf[6] = *(const u32x4*)((const char*)c.ATP + (size_t)(itm) * 8192 + soff[6]); } while (0)
#define DN_STORE() do { _Pragma("unroll") for (int k = 0; k < 7; ++k) *(LAS u32x4*)(lds + doff[k]) = pf[k]; } while (0)
    DN_LOAD(it0); DN_STORE();
    __syncthreads();
    f32x4 S[8];
#pragma unroll
    for (int i = 0; i < 8; ++i) S[i] = (f32x4){0.f, 0.f, 0.f, 0.f};
    const int ft = tid >> 3, fc = (tid & 7) * 16;
    f32x4 nw[4];
#pragma unroll
    for (int k = 0; k < 4; ++k) nw[k] = *(const f32x4*)(p.in[I_DNW] + l * 128 + fc + 4 * k);
    u32x2 uu[4], un[4]; float gl = c.GL[it0], gln = 0.f;
#pragma unroll
    for (int m = 0; m < 4; ++m) { uu[m] = *(const u32x2*)(c.UTP + (size_t)it0 * 8192 + dvc * 64 + 16 * m + 4 * q); un[m] = uu[m]; }
    for (int n = 0; n < 32; ++n) {
        const int itm = it0 + n * 4;
        if (n + 1 < 32) {
#pragma unroll
            for (int m = 0; m < 4; ++m) un[m] = *(const u32x2*)(c.UTP + (size_t)(itm + 4) * 8192 + dvc * 64 + 16 * m + 4 * q);
            gln = c.GL[itm + 4];
        }
        const u32x4 zr0 = *(const u32x4*)(c.PROJ + (size_t)(b * SEQ + n * 64 + ft) * NPROJ + C_Z + h * 128 + fc), zr1 = *(const u32x4*)(c.PROJ + (size_t)(b * SEQ + n * 64 + ft) * NPROJ + C_Z + h * 128 + fc + 8);
        if (n + 1 < 32) DN_LOAD(itm + 4);
        bf16x8 Sb[4];
#pragma unroll
        for (int s = 0; s < 4; ++s) { union { u32x4 u; bf16x8 v; } t; t.u.x = pk2(S[2 * s][0], S[2 * s][1]); t.u.y = pk2(S[2 * s][2], S[2 * s][3]); t.u.z = pk2(S[2 * s + 1][0], S[2 * s + 1][1]); t.u.w = pk2(S[2 * s + 1][2], S[2 * s + 1][3]); Sb[s] = t.v; }
        f32x4 vn[4]; bf16x8 vb[2]; bf16x8 fa[6], fb[6];
        fa[0] = *(const LAS bf16x8*)(wl + (16 * 0 + fr) * 272 + 64 * 0 + 16 * q); fa[1] = *(const LAS bf16x8*)(wl + (16 * 0 + fr) * 272 + 64 * 1 + 16 * q); fa[2] = *(const LAS bf16x8*)(wl + (16 * 0 + fr) * 272 + 64 * 2 + 16 * q); fa[3] = *(const LAS bf16x8*)(wl + (16 * 0 + fr) * 272 + 64 * 3 + 16 * q);
        fb[0] = *(const LAS bf16x8*)(wl + (16 * 1 + fr) * 272 + 64 * 0 + 16 * q); fb[1] = *(const LAS bf16x8*)(wl + (16 * 1 + fr) * 272 + 64 * 1 + 16 * q); fb[2] = *(const LAS bf16x8*)(wl + (16 * 1 + fr) * 272 + 64 * 2 + 16 * q); fb[3] = *(const LAS bf16x8*)(wl + (16 * 1 + fr) * 272 + 64 * 3 + 16 * q);
        __builtin_amdgcn_sched_barrier(0);
            { f32x4 P = {0.f, 0.f, 0.f, 0.f};
              P = __builtin_amdgcn_mfma_f32_16x16x32_bf16(fa[0], Sb[0], P, 0, 0, 0);
              P = __builtin_amdgcn_mfma_f32_16x16x32_bf16(fa[1], Sb[1], P, 0, 0, 0);
              P = __builtin_amdgcn_mfma_f32_16x16x32_bf16(fa[2], Sb[2], P, 0, 0, 0);
              P = __builtin_amdgcn_mfma_f32_16x16x32_bf16(fa[3], Sb[3], P, 0, 0, 0);
              vn[0][0] = __uint_as_float(uu[0].x << 16) - P[0]; vn[0][1] = __uint_as_float(uu[0].x & 0xffff0000u) - P[1]; vn[0][2] = __uint_as_float(uu[0].y << 16) - P[2]; vn[0][3] = __uint_as_float(uu[0].y & 0xffff0000u) - P[3]; }
        __builtin_amdgcn_sched_barrier(0);
        fa[0] = *(const LAS bf16x8*)(wl + (16 * 2 + fr) * 272 + 64 * 0 + 16 * q); fa[1] = *(const LAS bf16x8*)(wl + (16 * 2 + fr) * 272 + 64 * 1 + 16 * q); fa[2] = *(const LAS bf16x8*)(wl + (16 * 2 + fr) * 272 + 64 * 2 + 16 * q); fa[3] = *(const LAS bf16x8*)(wl + (16 * 2 + fr) * 272 + 64 * 3 + 16 * q);
        __builtin_amdgcn_sched_barrier(0);
            { f32x4 P = {0.f, 0.f, 0.f, 0.f};
              P = __builtin_amdgcn_mfma_f32_16x16x32_bf16(fb[0], Sb[0], P, 0, 0, 0);
              P = __builtin_amdgcn_mfma_f32_16x16x32_bf16(fb[1], Sb[1], P, 0, 0, 0);
              P = __builtin_amdgcn_mfma_f32_16x16x32_bf16(fb[2], Sb[2], P, 0, 0, 0);
              P = __builtin_amdgcn_mfma_f32_16x16x32_bf16(fb[3], Sb[3], P, 0, 0, 0);
              vn[1][0] = __uint_as_float(uu[1].x << 16) - P[0]; vn[1][1] = __uint_as_float(uu[1].x & 0xffff0000u) - P[1]; vn[1][2] = __uint_as_float(uu[1].y << 16) - P[2]; vn[1][3] = __uint_as_float(uu[1].y & 0xffff0000u) - P[3]; }
        __builtin_amdgcn_sched_barrier(0);
        fb[0] = *(const LAS bf16x8*)(wl + (16 * 3 + fr) * 272 + 64 * 0 + 16 * q); fb[1] = *(const LAS bf16x8*)(wl + (16 * 3 + fr) * 272 + 64 * 1 + 16 * q); fb[2] = *(const LAS bf16x8*)(wl + (16 * 3 + fr) * 272 + 64 * 2 + 16 * q); fb[3] = *(const LAS bf16x8*)(wl + (16 * 3 + fr) * 272 + 64 * 3 + 16 * q);
        __builtin_amdgcn_sched_barrier(0);
            { f32x4 P = {0.f, 0.f, 0.f, 0.f};
              P = __builtin_amdgcn_mfma_f32_16x16x32_bf16(fa[0], Sb[0], P, 0, 0, 0);
              P = __builtin_amdgcn_mfma_f32_16x16x32_bf16(fa[1], Sb[1], P, 0, 0, 0);
              P = __builtin_amdgcn_mfma_f32_16x16x32_bf16(fa[2], Sb[2], P, 0, 0, 0);
              P = __builtin_amdgcn_mfma_f32_16x16x32_bf16(fa[3], Sb[3], P, 0, 0, 0);
              vn[2][0] = __uint_as_float(uu[2].x << 16) - P[0]; vn[2][1] = __uint_as_float(uu[2].x & 0xffff0000u) - P[1]; vn[2][2] = __uint_as_float(uu[2].y << 16) - P[2]; vn[2][3] = __uint_as_float(uu[2].y & 0xffff0000u) - P[3]; }
        __builtin_amdgcn_sched_barrier(0);
        fa[0] = *(const LAS bf16x8*)(ql + (16 * 0 + fr) * 272 + 64 * 0 + 16 * q); fa[1] = *(const LAS bf16x8*)(ql + (16 * 0 + fr) * 272 + 64 * 1 + 16 * q); fa[2] = *(const LAS bf16x8*)(ql + (16 * 0 + fr) * 272 + 64 * 2 + 16 * q); fa[3] = *(const LAS bf16x8*)(ql + (16 * 0 + fr) * 272 + 64 * 3 + 16 * q); fa[4] = *(const LAS bf16x8*)(al + (16 * 0 + fr) * 144 + 64 * 0 + 16 * q); fa[5] = *(const LAS bf16x8*)(al + (16 * 0 + fr) * 144 + 64 * 1 + 16 * q);
        __builtin_amdgcn_sched_barrier(0);
            { f32x4 P = {0.f, 0.f, 0.f, 0.f};
              P = __builtin_amdgcn_mfma_f32_16x16x32_bf16(fb[0], Sb[0], P, 0, 0, 0);
              P = __builtin_amdgcn_mfma_f32_16x16x32_bf16(fb[1], Sb[1], P, 0, 0, 0);
              P = __builtin_amdgcn_mfma_f32_16x16x32_bf16(fb[2], Sb[2], P, 0, 0, 0);
              P = __builtin_amdgcn_mfma_f32_16x16x32_bf16(fb[3], Sb[3], P, 0, 0, 0);
              vn[3][0] = __uint_as_float(uu[3].x << 16) - P[0]; vn[3][1] = __uint_as_float(uu[3].x & 0xffff0000u) - P[1]; vn[3][2] = __uint_as_float(uu[3].y << 16) - P[2]; vn[3][3] = __uint_as_float(uu[3].y & 0xffff0000u) - P[3]; }
            for (int s = 0; s < 2; ++s) { union { u32x4 u; bf16x8 v; } t; t.u.x = pk2(vn[2 * s][0], vn[2 * s][1]); t.u.y = pk2(vn[2 * s][2], vn[2 * s][3]); t.u.z = pk2(vn[2 * s + 1][0], vn[2 * s + 1][1]); t.u.w = pk2(vn[2 * s + 1][2], vn[2 * s + 1][3]); vb[s] = t.v; }
        __builtin_amdgcn_sched_barrier(0);
        fb[0] = *(const LAS bf16x8*)(ql + (16 * 1 + fr) * 272 + 64 * 0 + 16 * q); fb[1] = *(const LAS bf16x8*)(ql + (16 * 1 + fr) * 272 + 64 * 1 + 16 * q); fb[2] = *(const LAS bf16x8*)(ql + (16 * 1 + fr) * 272 + 64 * 2 + 16 * q); fb[3] = *(const LAS bf16x8*)(ql + (16 * 1 + fr) * 272 + 64 * 3 + 16 * q); fb[4] = *(const LAS bf16x8*)(al + (16 * 1 + fr) * 144 + 64 * 0 + 16 * q); fb[5] = *(const LAS bf16x8*)(al + (16 * 1 + fr) * 144 + 64 * 1 + 16 * q);
        __builtin_amdgcn_sched_barrier(0);
            { f32x4 O = {0.f, 0.f, 0.f, 0.f};
              O = __builtin_amdgcn_mfma_f32_16x16x32_bf16(fa[0], Sb[0], O, 0, 0, 0);
              O = __builtin_amdgcn_mfma_f32_16x16x32_bf16(fa[1], Sb[1], O, 0, 0, 0);
              O = __builtin_amdgcn_mfma_f32_16x16x32_bf16(fa[2], Sb[2], O, 0, 0, 0);
              O = __builtin_amdgcn_mfma_f32_16x16x32_bf16(fa[3], Sb[3], O, 0, 0, 0);
              O = __builtin_amdgcn_mfma_f32_16x16x32_bf16(fa[4], vb[0], O, 0, 0, 0);
              O = __builtin_amdgcn_mfma_f32_16x16x32_bf16(fa[5], vb[1], O, 0, 0, 0);
              for (int r = 0; r < 4; ++r) obuf[(16 * 0 + 4 * q + r) * 132 + dvc] = O[r]; }
        __builtin_amdgcn_sched_barrier(0);
        fa[0] = *(const LAS bf16x8*)(ql + (16 * 2 + fr) * 272 + 64 * 0 + 16 * q); fa[1] = *(const LAS bf16x8*)(ql + (16 * 2 + fr) * 272 + 64 * 1 + 16 * q); fa[2] = *(const LAS bf16x8*)(ql + (16 * 2 + fr) * 272 + 64 * 2 + 16 * q); fa[3] = *(const LAS bf16x8*)(ql + (16 * 2 + fr) * 272 + 64 * 3 + 16 * q); fa[4] = *(const LAS bf16x8*)(al + (16 * 2 + fr) * 144 + 64 * 0 + 16 * q); fa[5] = *(const LAS bf16x8*)(al + (16 * 2 + fr) * 144 + 64 * 1 + 16 * q);
        __builtin_amdgcn_sched_barrier(0);
            { f32x4 O = {0.f, 0.f, 0.f, 0.f};
              O = __builtin_amdgcn_mfma_f32_16x16x32_bf16(fb[0], Sb[0], O, 0, 0, 0);
              O = __builtin_amdgcn_mfma_f32_16x16x32_bf16(fb[1], Sb[1], O, 0, 0, 0);
              O = __builtin_amdgcn_mfma_f32_16x16x32_bf16(fb[2], Sb[2], O, 0, 0, 0);
              O = __builtin_amdgcn_mfma_f32_16x16x32_bf16(fb[3], Sb[3], O, 0, 0, 0);
              O = __builtin_amdgcn_mfma_f32_16x16x32_bf16(fb[4], vb[0], O, 0, 0, 0);
              O = __builtin_amdgcn_mfma_f32_16x16x32_bf16(fb[5], vb[1], O, 0, 0, 0);
              for (int r = 0; r < 4; ++r) obuf[(16 * 1 + 4 * q + r) * 132 + dvc] = O[r]; }
        __builtin_amdgcn_sched_barrier(0);
        fb[0] = *(const LAS bf16x8*)(ql + (16 * 3 + fr) * 272 + 64 * 0 + 16 * q); fb[1] = *(const LAS bf16x8*)(ql + (16 * 3 + fr) * 272 + 64 * 1 + 16 * q); fb[2] = *(const LAS bf16x8*)(ql + (16 * 3 + fr) * 272 + 64 * 2 + 16 * q); fb[3] = *(const LAS bf16x8*)(ql + (16 * 3 + fr) * 272 + 64 * 3 + 16 * q); fb[4] = *(const LAS bf16x8*)(al + (16 * 3 + fr) * 144 + 64 * 0 + 16 * q); fb[5] = *(const LAS bf16x8*)(al + (16 * 3 + fr) * 144 + 64 * 1 + 16 * q);
        __builtin_amdgcn_sched_barrier(0);
            { f32x4 O = {0.f, 0.f, 0.f, 0.f};
              O = __builtin_amdgcn_mfma_f32_16x16x32_bf16(fa[0], Sb[0], O, 0, 0, 0);
              O = __builtin_amdgcn_mfma_f32_16x16x32_bf16(fa[1], Sb[1], O, 0, 0, 0);
              O = __builtin_amdgcn_mfma_f32_16x16x32_bf16(fa[2], Sb[2], O, 0, 0, 0);
              O = __builtin_amdgcn_mfma_f32_16x16x32_bf16(fa[3], Sb[3], O, 0, 0, 0);
              O = __builtin_amdgcn_mfma_f32_16x16x32_bf16(fa[4], vb[0], O, 0, 0, 0);
              O = __builtin_amdgcn_mfma_f32_16x16x32_bf16(fa[5], vb[1], O, 0, 0, 0);
              for (int r = 0; r < 4; ++r) obuf[(16 * 2 + 4 * q + r) * 132 + dvc] = O[r]; }
        __builtin_amdgcn_sched_barrier(0);
        fa[0] = *(const LAS bf16x8*)(kl + (16 * 0 + fr) * 144 + 64 * 0 + 16 * q); fa[1] = *(const LAS bf16x8*)(kl + (16 * 0 + fr) * 144 + 64 * 1 + 16 * q); fa[2] = *(const LAS bf16x8*)(kl + (16 * 1 + fr) * 144 + 64 * 0 + 16 * q); fa[3] = *(const LAS bf16x8*)(kl + (16 * 1 + fr) * 144 + 64 * 1 + 16 * q);
        __builtin_amdgcn_sched_barrier(0);
            { f32x4 O = {0.f, 0.f, 0.f, 0.f};
              O = __builtin_amdgcn_mfma_f32_16x16x32_bf16(fb[0], Sb[0], O, 0, 0, 0);
              O = __builtin_amdgcn_mfma_f32_16x16x32_bf16(fb[1], Sb[1], O, 0, 0, 0);
              O = __builtin_amdgcn_mfma_f32_16x16x32_bf16(fb[2], Sb[2], O, 0, 0, 0);
              O = __builtin_amdgcn_mfma_f32_16x16x32_bf16(fb[3], Sb[3], O, 0, 0, 0);
              O = __builtin_amdgcn_mfma_f32_16x16x32_bf16(fb[4], vb[0], O, 0, 0, 0);
              O = __builtin_amdgcn_mfma_f32_16x16x32_bf16(fb[5], vb[1], O, 0, 0, 0);
              for (int r = 0; r < 4; ++r) obuf[(16 * 3 + 4 * q + r) * 132 + dvc] = O[r]; }
        __builtin_amdgcn_sched_barrier(0);
        fb[0] = *(const LAS bf16x8*)(kl + (16 * 2 + fr) * 144 + 64 * 0 + 16 * q); fb[1] = *(const LAS bf16x8*)(kl + (16 * 2 + fr) * 144 + 64 * 1 + 16 * q); fb[2] = *(const LAS bf16x8*)(kl + (16 * 3 + fr) * 144 + 64 * 0 + 16 * q); fb[3] = *(const LAS bf16x8*)(kl + (16 * 3 + fr) * 144 + 64 * 1 + 16 * q);
        __builtin_amdgcn_sched_barrier(0);
            { f32x4 a0 = S[0] * gl; a0 = __builtin_amdgcn_mfma_f32_16x16x32_bf16(fa[0], vb[0], a0, 0, 0, 0); a0 = __builtin_amdgcn_mfma_f32_16x16x32_bf16(fa[1], vb[1], a0, 0, 0, 0); S[0] = a0; f32x4 a1 = S[1] * gl; a1 = __builtin_amdgcn_mfma_f32_16x16x32_bf16(fa[2], vb[0], a1, 0, 0, 0); a1 = __builtin_amdgcn_mfma_f32_16x16x32_bf16(fa[3], vb[1], a1, 0, 0, 0); S[1] = a1; }
        __builtin_amdgcn_sched_barrier(0);
        fa[0] = *(const LAS bf16x8*)(kl + (16 * 4 + fr) * 144 + 64 * 0 + 16 * q); fa[1] = *(const LAS bf16x8*)(kl + (16 * 4 + fr) * 144 + 64 * 1 + 16 * q); fa[2] = *(const LAS bf16x8*)(kl + (16 * 5 + fr) * 144 + 64 * 0 + 16 * q); fa[3] = *(const LAS bf16x8*)(kl + (16 * 5 + fr) * 144 + 64 * 1 + 16 * q);
        __builtin_amdgcn_sched_barrier(0);
            { f32x4 a0 = S[2] * gl; a0 = __builtin_amdgcn_mfma_f32_16x16x32_bf16(fb[0], vb[0], a0, 0, 0, 0); a0 = __builtin_amdgcn_mfma_f32_16x16x32_bf16(fb[1], vb[1], a0, 0, 0, 0); S[2] = a0; f32x4 a1 = S[3] * gl; a1 = __builtin_amdgcn_mfma_f32_16x16x32_bf16(fb[2], vb[0], a1, 0, 0, 0); a1 = __builtin_amdgcn_mfma_f32_16x16x32_bf16(fb[3], vb[1], a1, 0, 0, 0); S[3] = a1; }
        __builtin_amdgcn_sched_barrier(0);
        fb[0] = *(const LAS bf16x8*)(kl + (16 * 6 + fr) * 144 + 64 * 0 + 16 * q); fb[1] = *(const LAS bf16x8*)(kl + (16 * 6 + fr) * 144 + 64 * 1 + 16 * q); fb[2] = *(const LAS bf16x8*)(kl + (16 * 7 + fr) * 144 + 64 * 0 + 16 * q); fb[3] = *(const LAS bf16x8*)(kl + (16 * 7 + fr) * 144 + 64 * 1 + 16 * q);
        __builtin_amdgcn_sched_barrier(0);
            { f32x4 a0 = S[4] * gl; a0 = __builtin_amdgcn_mfma_f32_16x16x32_bf16(fa[0], vb[0], a0, 0, 0, 0); a0 = __builtin_amdgcn_mfma_f32_16x16x32_bf16(fa[1], vb[1], a0, 0, 0, 0); S[4] = a0; f32x4 a1 = S[5] * gl; a1 = __builtin_amdgcn_mfma_f32_16x16x32_bf16(fa[2], vb[0], a1, 0, 0, 0); a1 = __builtin_amdgcn_mfma_f32_16x16x32_bf16(fa[3], vb[1], a1, 0, 0, 0); S[5] = a1; }
        __builtin_amdgcn_sched_barrier(0);
        __builtin_amdgcn_sched_barrier(0);
            { f32x4 a0 = S[6] * gl; a0 = __builtin_amdgcn_mfma_f32_16x16x32_bf16(fb[0], vb[0], a0, 0, 0, 0); a0 = __builtin_amdgcn_mfma_f32_16x16x32_bf16(fb[1], vb[1], a0, 0, 0, 0); S[6] = a0; f32x4 a1 = S[7] * gl; a1 = __builtin_amdgcn_mfma_f32_16x16x32_bf16(fb[2], vb[0], a1, 0, 0, 0); a1 = __builtin_amdgcn_mfma_f32_16x16x32_bf16(fb[3], vb[1], a1, 0, 0, 0); S[7] = a1; }
        __builtin_amdgcn_sched_barrier(0);
        __syncthreads();
        if (n + 1 < 32) DN_STORE();
#pragma unroll
        for (int m = 0; m < 4; ++m) uu[m] = un[m];
        gl = gln;
        {
            const int row = b * SEQ + n * 64 + ft;
            f32x4 o4[4]; float ss = 0.f;
#pragma unroll
            for (int k = 0; k < 4; ++k) { o4[k] = *(const LAS f32x4*)(obuf + ft * 132 + fc + 4 * k); ss += (o4[k][0] * o4[k][0] + o4[k][1] * o4[k][1]) + (o4[k][2] * o4[k][2] + o4[k][3] * o4[k][3]); }
            ss += __shfl_xor(ss, 1); ss += __shfl_xor(ss, 2); ss += __shfl_xor(ss, 4);
            const float rs = rsqrtf(ss * (1.f / 128.f) + 1e-6f);
            float z[16]; { float z0[8], z1[8]; unpack8(zr0, z0); unpack8(zr1, z1);
#pragma unroll
                for (int e = 0; e < 8; ++e) { z[e] = z0[e]; z[8 + e] = z1[e]; } }
            float o[16];
#pragma unroll
            for (int e = 0; e < 16; ++e) o[e] = o4[e >> 2][e & 3] * rs * nw[e >> 2][e & 3] * siluf_(z[e]);
            u32x4 w0, w1; w0.x = pk2(o[0], o[1]); w0.y = pk2(o[2], o[3]); w0.z = pk2(o[4], o[5]); w0.w = pk2(o[6], o[7]); w1.x = pk2(o[8], o[9]); w1.y = pk2(o[10], o[11]); w1.z = pk2(o[12], o[13]); w1.w = pk2(o[14], o[15]);
            *(u32x4*)(c.OAB + (size_t)row * D + h * 128 + fc) = w0; *(u32x4*)(c.OAB + (size_t)row * D + h * 128 + fc + 8) = w1;
        }
        __syncthreads();
    }
#undef DN_LOAD
#undef DN_STORE
    float* So = p.out + O_PDN + (size_t)((l * NBATCH + b) * 4 + h) * 16384;
#pragma unroll
    for (int i = 0; i < 8; ++i)
#pragma unroll
        for (int r = 0; r < 4; ++r) So[(size_t)(16 * i + 4 * q + r) * 128 + dvc] = S[i][r];
    __syncthreads();
}

DEV void lru_items(const Ctx& c, int l, int first, int stride, int total, int mode, LAS unsigned char* lds) {
    if (first >= total) return;
    const Params& p = *c.p;
    const int blk = first & 3, tid = c.tid, lane = c.lane;
    LAS float* xc = (LAS float*)lds;
    const int w = c.wave, fr = lane & 15, q = lane >> 4, d = 16 * w + fr, ch = blk * 128 + d;
    bf16x8 ba_[4], bx_[4];
    {
        const bf16_t* waT = (const bf16_t*)(wbuf(c, l) + WO_LWA) + (size_t)(blk * 128 + d) * 128 + 8 * q;
        const bf16_t* wxT = (const bf16_t*)(wbuf(c, l) + WO_LWX) + (size_t)(blk * 128 + d) * 128 + 8 * q;
#pragma unroll
        for (int s = 0; s < 4; ++s) { ba_[s] = *(const bf16x8*)(waT + 32 * s); bx_[s] = *(const bf16x8*)(wxT + 32 * s); }
    }
    const float bias_a = p.in[I_LBA][l * 512 + ch], bias_x = p.in[I_LBX][l * 512 + ch];
    const float spl = softplus_(-p.in[I_LAM][l * 512 + ch]);
    const int cr = tid >> 3, c0 = (tid & 7) * 16;
    u32x4 pre[2][4];
#define LRU_PREF(item) do { const int _row = ((item) >> 2) * 64 + cr; _Pragma("unroll") for (int hf = 0; hf < 2; ++hf) _Pragma("unroll") for (int j = 0; j < 4; ++j) { \
        const int _rr = _row - 3 + j; pre[hf][j] = *(const u32x4*)(c.PROJ + (size_t)(_rr < 0 ? 0 : _rr) * NPROJ + C_LX + blk * 128 + c0 + hf * 8); } } while (0)
    LRU_PREF(first);
    for (int item = first; item < total; item += stride) {
        const int rt = item >> 2, row0 = rt * 64;
        {
            const int row = row0 + cr;
            int pos, sb = 0; const float* hist = nullptr;
            if (row < MP) pos = row & (SEQ - 1); else { sb = (row - MP) >> 2; pos = (row - MP) & 3; hist = p.in[I_SLC] + (size_t)(l * SBATCH + sb) * 3 * 512; }
#pragma unroll
            for (int hf = 0; hf < 2; ++hf) {
                const int cc = blk * 128 + c0 + hf * 8;
                float a[8], own[8];
                { const f32x4 b0 = *(const f32x4*)(p.in[I_LCB] + l * 512 + cc), b1 = *(const f32x4*)(p.in[I_LCB] + l * 512 + cc + 4);
                  a[0] = b0[0]; a[1] = b0[1]; a[2] = b0[2]; a[3] = b0[3]; a[4] = b1[0]; a[5] = b1[1]; a[6] = b1[2]; a[7] = b1[3]; }
#pragma unroll
                for (int j = 0; j < 4; ++j) {
                    float v[8];
                    const int sp = pos - 3 + j;
                    unpack8(pre[hf][j], v);
                    if (sp < 0) {
                        if (hist) { const f32x4 h0 = *(const f32x4*)(hist + (size_t)(pos + j) * 512 + cc), h1 = *(const f32x4*)(hist + (size_t)(pos + j) * 512 + cc + 4);
                            v[0] = h0[0]; v[1] = h0[1]; v[2] = h0[2]; v[3] = h0[3]; v[4] = h1[0]; v[5] = h1[1]; v[6] = h1[2]; v[7] = h1[3]; }
                        else {
#pragma unroll
                            for (int e = 0; e < 8; ++e) v[e] = 0.f; }
                    }
                    const float* cw = p.in[I_LCW] + (size_t)(l * 4 + j) * 512 + cc;
                    const f32x4 w0 = *(const f32x4*)cw, w1 = *(const f32x4*)(cw + 4);
#pragma unroll
                    for (int e = 0; e < 4; ++e) { a[e] += v[e] * w0[e]; a[e + 4] += v[e + 4] * w1[e]; }
                    if (j == 3) {
#pragma unroll
                        for (int e = 0; e < 8; ++e) own[e] = v[e]; }
                }
                *(LAS f32x4*)(xc + cr * 132 + c0 + hf * 8) = (f32x4){a[0], a[1], a[2], a[3]}; *(LAS f32x4*)(xc + cr * 132 + c0 + hf * 8 + 4) = (f32x4){a[4], a[5], a[6], a[7]};
                if (mode == 1) {
                    float* dst = nullptr;
                    if (row < MP) { if (pos >= SEQ - 3) dst = p.out + O_PLC + ((size_t)(l * NBATCH + (row >> 11)) * 3 + (pos - (SEQ - 3))) * 512 + cc; }
                    else if (pos >= 1) dst = p.out + O_SLC + ((size_t)(l * SBATCH + sb) * 3 + (pos - 1)) * 512 + cc;
                    if (dst) { *(f32x4*)dst = (f32x4){own[0], own[1], own[2], own[3]}; *(f32x4*)(dst + 4) = (f32x4){own[4], own[5], own[6], own[7]}; }
                }
            }
        }
        if (item + stride < total) LRU_PREF(item + stride);
        unsigned short yraw[4][4];
        float ca[8], chh[8];
        const int bq = rt >> 5, ci = rt & 31;
        if (mode == 1) {
#pragma unroll
            for (int m = 0; m < 4; ++m)
#pragma unroll
                for (int r = 0; r < 4; ++r) yraw[m][r] = c.PROJ[(size_t)(row0 + 16 * m + 4 * q + r) * NPROJ + C_LY + ch];
            if (row0 < MP) {
#pragma unroll
                for (int jj = 0; jj < 8; ++jj) { const size_t o = (size_t)((bq * 32 + 8 * q + jj) * 512 + ch); ca[jj] = c.CSA[o]; chh[jj] = c.CSH[o]; }
            }
        }
        __syncthreads();
        float av[4][4], bv[4][4];
#pragma unroll
        for (int m = 0; m < 4; ++m) {
            f32x4 aa = {0.f, 0.f, 0.f, 0.f}, ax = {0.f, 0.f, 0.f, 0.f};
#pragma unroll
            for (int s = 0; s < 4; ++s) {
                const LAS float* src = xc + (16 * m + fr) * 132 + 32 * s + 8 * q;
                const f32x4 x0 = *(const LAS f32x4*)src, x1 = *(const LAS f32x4*)(src + 4);
                union { u32x4 u; bf16x8 b; } af; af.u.x = pk2(x0[0], x0[1]); af.u.y = pk2(x0[2], x0[3]); af.u.z = pk2(x1[0], x1[1]); af.u.w = pk2(x1[2], x1[3]);
                aa = __builtin_amdgcn_mfma_f32_16x16x32_bf16(af.b, ba_[s], aa, 0, 0, 0);
                ax = __builtin_amdgcn_mfma_f32_16x16x32_bf16(af.b, bx_[s], ax, 0, 0, 0);
            }
#pragma unroll
            for (int r = 0; r < 4; ++r) {
                const int rowl = 16 * m + 4 * q + r, row = row0 + rowl;
                const float rr = sigm(aa[r] + bias_a), ii = sigm(ax[r] + bias_x);
                const float la = -8.f * rr * spl;
                float mult = sqrtf(neg_expm1(2.f * la));
                if (row < MP && (row & (SEQ - 1)) == 0) mult = 1.f;
                av[m][r] = __expf(la); bv[m][r] = mult * ii * xc[rowl * 132 + d];
            }
        }
        if (row0 < MP) {
            float carry = 0.f;
            if (mode == 1) {
                float Aq = 1.f, Hq = 0.f;
#pragma unroll
                for (int jj = 0; jj < 8; ++jj) { const bool on = (8 * q + jj) < ci; Hq = on ? ca[jj] * Hq + chh[jj] : Hq; Aq = on ? Aq * ca[jj] : Aq; }
#pragma unroll
                for (int qq = 0; qq < 4; ++qq) { const float A_ = __shfl(Aq, fr + 16 * qq), H_ = __shfl(Hq, fr + 16 * qq); carry = A_ * carry + H_; }
            }
            float tA = 1.f, tH = 0.f;
#pragma unroll
            for (int m = 0; m < 4; ++m) {
                float As = av[m][0], Bs = bv[m][0];
#pragma unroll
                for (int r = 1; r < 4; ++r) { Bs = av[m][r] * Bs + bv[m][r]; As *= av[m][r]; }
                float hs = carry, hn = carry;
#pragma unroll
                for (int qq = 0; qq < 4; ++qq) { const float Aq = __shfl(As, fr + 16 * qq), Bq = __shfl(Bs, fr + 16 * qq);
                    if (qq < q) hs = Aq * hs + Bq;
                    hn = Aq * hn + Bq;
                    tH = Aq * tH + Bq; tA *= Aq; }
                if (mode == 1) {
                    float hcur = hs;
#pragma unroll
                    for (int r = 0; r < 4; ++r) { const int row = row0 + 16 * m + 4 * q + r;
                        hcur = av[m][r] * hcur + bv[m][r];
                        c.OAB[(size_t)row * D + 512 + ch] = (bf16_t)f2bf(hcur * gelu_t(bf2f(yraw[m][r]))); }
                    if (ci == 31 && m == 3 && q == 3) p.out[O_PL + (size_t)(l * NBATCH + bq) * 512 + ch] = hcur;
                }
                carry = hn;
            }
            if (mode == 0 && q == 0) { const size_t o = (size_t)(rt * 512 + ch); c.CSA[o] = tA; c.CSH[o] = tH; }
        } else if (mode == 1) {
#pragma unroll
            for (int m = 0; m < 4; ++m) { const int sb = (rt - MP / 64) * 16 + 4 * m + q;
                float hcur = p.in[I_SL][(size_t)(l * SBATCH + sb) * 512 + ch];
#pragma unroll
                for (int r = 0; r < 4; ++r) { const int row = row0 + 16 * m + 4 * q + r;
                    hcur = av[m][r] * hcur + bv[m][r];
                    c.OAB[(size_t)row * D + 512 + ch] = (bf16_t)f2bf(hcur * gelu_t(bf2f(yraw[m][r]))); }
                p.out[O_SL + (size_t)(l * SBATCH + sb) * 512 + ch] = hcur; }
        }
        __syncthreads();
    }
#undef LRU_PREF
}

DEV void dn_scan_item(const Ctx& c, int l, int row0, int ntok, int h, const float* S0, float* Sout, LAS unsigned char* lds) {
    const Params& p = *c.p;
    const int tid = c.tid, kg = tid >> 7, v = tid & 127, lane = c.lane, wave = c.wave;
    LAS float* qk = (LAS float*)lds;
    LAS float* rpart = qk + 512;
    LAS float* opart = rpart + 512;
    LAS float* ssb = opart + 512;
    float S[32];
#pragma unroll
    for (int i = 0; i < 32; ++i) S[i] = S0 ? S0[(size_t)(32 * kg + i) * 128 + v] : 0.f;
    const float nw = p.in[I_DNW][l * 128 + v];
    const int qcol = (tid < 128) ? (h * 128 + tid) : (512 + h * 128 + (tid - 128));
    float pre = 0.f;
    if (tid < 256) { qk[tid] = bf2f(c.QKVN[(size_t)(row0 - MP) * 1536 + qcol]); if (ntok > 1) pre = bf2f(c.QKVN[(size_t)(row0 + 1 - MP) * 1536 + qcol]); }
    __syncthreads();
    float o_prev = 0.f;
    for (int t = 0; t < ntok; ++t) {
        const int row = row0 + t;
        const LAS float* cur = qk + (t & 1) * 256;
        const float vv = bf2f(c.QKVN[(size_t)(row - MP) * 1536 + 1024 + h * 128 + v]);
        const float g = c.GB[(size_t)(row - MP) * 8 + h], beta = c.GB[(size_t)(row - MP) * 8 + 4 + h];
        float r0 = 0.f, r1 = 0.f, r2 = 0.f, r3 = 0.f;
#pragma unroll
        for (int i = 0; i < 32; i += 4) { const f32x4 kk = *(const LAS f32x4*)(cur + 128 + 32 * kg + i);
            r0 += kk[0] * S[i]; r1 += kk[1] * S[i + 1]; r2 += kk[2] * S[i + 2]; r3 += kk[3] * S[i + 3]; }
        rpart[kg * 128 + v] = (r0 + r1) + (r2 + r3);
        if (tid < 256) { qk[((t + 1) & 1) * 256 + tid] = pre; if (t + 2 < ntok) pre = bf2f(c.QKVN[(size_t)(row + 2 - MP) * 1536 + qcol]); }
        __syncthreads();
        const float r = (rpart[v] + rpart[128 + v]) + (rpart[256 + v] + rpart[384 + v]);
        const float eg = __expf(g), dd = beta * (vv - eg * r);
        float o0 = 0.f, o1 = 0.f, o2 = 0.f, o3 = 0.f;
#pragma unroll
        for (int i = 0; i < 32; i += 4) { const f32x4 kk = *(const LAS f32x4*)(cur + 128 + 32 * kg + i), qq = *(const LAS f32x4*)(cur + 32 * kg + i);
            S[i] = eg * S[i] + kk[0] * dd; S[i + 1] = eg * S[i + 1] + kk[1] * dd; S[i + 2] = eg * S[i + 2] + kk[2] * dd; S[i + 3] = eg * S[i + 3] + kk[3] * dd;
            o0 += qq[0] * S[i]; o1 += qq[1] * S[i + 1]; o2 += qq[2] * S[i + 2]; o3 += qq[3] * S[i + 3]; }
        opart[kg * 128 + v] = (o0 + o1) + (o2 + o3);
        if (tid < 128 && t > 0) {
            const float ss = ssb[((t - 1) & 1) * 2] + ssb[((t - 1) & 1) * 2 + 1];
            const float rs = rsqrtf(ss * (1.f / 128.f) + 1e-6f);
            const float z = bf2f(c.PROJ[(size_t)(row - 1) * NPROJ + C_Z + h * 128 + v]);
            c.OAB[(size_t)(row - 1) * D + h * 128 + v] = (bf16_t)f2bf(o_prev * rs * nw * siluf_(z));
        }
        __syncthreads();
        if (tid < 128) { o_prev = (opart[v] + opart[128 + v]) + (opart[256 + v] + opart[384 + v]); const float s2 = wave_sum(o_prev * o_prev); if (lane == 0) ssb[(t & 1) * 2 + wave] = s2; }
    }
    __syncthreads();
    if (tid < 128) {
        const int t = ntok - 1, row = row0 + t;
        const float ss = ssb[(t & 1) * 2] + ssb[(t & 1) * 2 + 1];
        const float rs = rsqrtf(ss * (1.f / 128.f) + 1e-6f);
        const float z = bf2f(c.PROJ[(size_t)row * NPROJ + C_Z + h * 128 + v]);
        c.OAB[(size_t)row * D + h * 128 + v] = (bf16_t)f2bf(o_prev * rs * nw * siluf_(z));
    }
#pragma unroll
    for (int i = 0; i < 32; ++i) Sout[(size_t)(32 * kg + i) * 128 + v] = S[i];
    __syncthreads();
}

DEV void ffn_act(const Ctx& c, int l) {
    const Params& p = *c.p;
    const int GT = c.G * 512;
    for (int idx = c.bid * 512 + c.tid; idx < (M / 16) * 384; idx += GT) {
        const int rg = idx / 384, cg_ = idx - rg * 384, f0 = cg_ * 8, row0 = rg * 16;
        float w0[8], w1[8], w2[8], g1[8], g2[8];
        { const float* fw = p.in[I_FCW] + (size_t)l * 3 * DFF + f0;
#pragma unroll
          for (int e = 0; e < 8; ++e) { w0[e] = fw[e]; w1[e] = fw[DFF + e]; w2[e] = fw[2 * DFF + e]; g1[e] = 0.f; g2[e] = 0.f; } }
        if (row0 < MP && (row0 & (SEQ - 1)) != 0) { unpack8(*(const u32x4*)(c.HB + (size_t)(row0 - 1) * 2 * DFF + f0), g1); unpack8(*(const u32x4*)(c.HB + (size_t)(row0 - 2) * 2 * DFF + f0), g2); }
#pragma unroll
        for (int rb = 0; rb < 2; ++rb) {
            u32x4 gr[8], ur[8];
#pragma unroll
            for (int r = 0; r < 8; ++r) { const int row = row0 + rb * 8 + r; gr[r] = *(const u32x4*)(c.HB + (size_t)row * 2 * DFF + f0); ur[r] = *(const u32x4*)(c.HB + (size_t)row * 2 * DFF + DFF + f0); }
#pragma unroll
            for (int r = 0; r < 8; ++r) {
                const int row = row0 + rb * 8 + r;
                int pos, sb = 0;
                if (row < MP) pos = row & (SEQ - 1); else { sb = (row - MP) >> 2; pos = (row - MP) & 3;
                    if (pos == 0) { const float* st = p.in[I_SFC] + (size_t)(l * SBATCH + sb) * 2 * DFF + f0;
#pragma unroll
                        for (int e = 0; e < 8; ++e) { g2[e] = st[e]; g1[e] = st[DFF + e]; } } }
                float g0[8], u[8], o[8];
                unpack8(gr[r], g0); unpack8(ur[r], u);
#pragma unroll
                for (int e = 0; e < 8; ++e) { const float y = w0[e] * g2[e] + w1[e] * g1[e] + w2[e] * g0[e]; o[e] = gelu_t(y) * u[e]; }
                *(u32x4*)(c.HB + (size_t)row * 2 * DFF + DFF + f0) = pack8(o);
                float* dst = nullptr;
                if (row < MP) { if (pos >= SEQ - 2) dst = p.out + O_PFC + ((size_t)(l * NBATCH + (row >> 11)) * 2 + (pos - (SEQ - 2))) * DFF + f0; }
                else if (pos >= 2) dst = p.out + O_SFC + ((size_t)(l * SBATCH + sb) * 2 + (pos - 2)) * DFF + f0;
                if (dst) { *(f32x4*)dst = (f32x4){g0[0], g0[1], g0[2], g0[3]}; *(f32x4*)(dst + 4) = (f32x4){g0[4], g0[5], g0[6], g0[7]}; }
#pragma unroll
                for (int e = 0; e < 8; ++e) { g2[e] = g1[e]; g1[e] = g0[e]; }
            }
        }
    }
}

DEV void sample_fixup(const Ctx& c) {
    const int gw = c.bid * 8 + c.wave, NGW = c.G * 8;
    const float* Z = (const float*)(c.ws + WS_Z);
    for (int r = gw; r < MS; r += NGW) {
        const int row = MP + r; float ss = 0.f;
#pragma unroll
        for (int j = 0; j < 4; ++j) {
            const size_t o = (size_t)r * D + j * 256 + c.lane * 4;
            const f32x4 z = (*(const f32x4*)(Z + o) + *(const f32x4*)(Z + (size_t)MS * D + o)) + *(const f32x4*)(Z + (size_t)2 * MS * D + o);
            const u32x2 xi = *(const u32x2*)(c.XB + (size_t)row * D + j * 256 + c.lane * 4);
            const float x0 = __uint_as_float(xi.x << 16) + z[0], x1 = __uint_as_float(xi.x & 0xffff0000u) + z[1], x2 = __uint_as_float(xi.y << 16) + z[2], x3 = __uint_as_float(xi.y & 0xffff0000u) + z[3];
            u32x2 w; w.x = pk2(x0, x1); w.y = pk2(x2, x3); *(u32x2*)(c.XB + (size_t)row * D + j * 256 + c.lane * 4) = w;
            const float r0 = __uint_as_float(w.x << 16), r1 = __uint_as_float(w.x & 0xffff0000u), r2 = __uint_as_float(w.y << 16), r3 = __uint_as_float(w.y & 0xffff0000u);
            ss += (r0 * r0 + r1 * r1) + (r2 * r2 + r3 * r3);
        }
        ss = wave_sum(ss);
        if (c.lane < NSLOT) c.SSQ[(size_t)row * NSLOT + c.lane] = (c.lane == 0) ? ss : 0.f;
    }
}

DEV void final_norm(const Ctx& c) {
    const int gw = c.bid * 8 + c.wave, NGW = c.G * 8;
    const float* fw = c.p->in[I_FNW];
    for (int row = gw; row < M; row += NGW) {
        float s = 0.f;
#pragma unroll
        for (int k = 0; k < NSLOT; ++k) s += c.SSQ[(size_t)row * NSLOT + k];
        const float rs = rsqrtf(s * (1.f / 1024.f) + 1e-6f);
#pragma unroll
        for (int j = 0; j < 4; ++j) { const u32x2 xi = *(const u32x2*)(c.XB + (size_t)row * D + j * 256 + c.lane * 4); const f32x4 w = *(const f32x4*)(fw + j * 256 + c.lane * 4);
            const f32x4 v = {__uint_as_float(xi.x << 16), __uint_as_float(xi.x & 0xffff0000u), __uint_as_float(xi.y << 16), __uint_as_float(xi.y & 0xffff0000u)};
            *(f32x4*)(c.p->out + (size_t)row * D + j * 256 + c.lane * 4) = v * rs * w; }
    }
}

__global__ void __launch_bounds__(512, 2) mega(Params prm) {
    extern __shared__ __attribute__((aligned(16))) unsigned char lds_raw[];
    LAS unsigned char* lds = (LAS unsigned char*)lds_raw;
    cg::grid_group grid = cg::this_grid();
    volatile LAS unsigned* bst = (volatile LAS unsigned*)(lds + 147200);
    if (threadIdx.x < 2) bst[threadIdx.x] = 0u;
    __syncthreads();
    const XcdBarrier xbar = xcd_barrier_post((unsigned*)prm.ws, bst);

    { const Ctx c = mk(prm); convert_layer(c, 0, c.bid * 8 + c.wave, c.G * 8, lds); x_prologue(c); }
    grid.sync();

    for (int l = 0; l < DEPTH; ++l) {
        { const Ctx c = mk(prm); unsigned char* wb = wbuf(c, l);
          pg8::Gemm g{c.XB, (const bf16_t*)(wb + WO_WIN), D, D, D}; pg8::StaticOrder S; S.init(M, NPROJ, c.G, c.bid);
          pg8::EpiScaleBf16 E{c.PROJ, NPROJ, c.SSQ};
          pg8::gemm_phase<pg8::EpiScaleBf16, pg8::StaticOrder, 0>(lds, g, S, E); }
        xcd_barrier(xbar);
        { const Ctx c = mk(prm); for (int it = c.bid; it < NBATCH * 32 * 4; it += c.G) dn_chunk_prep(c, l, it, lds); }
        { const Ctx c = mk(prm); lru_items(c, l, c.bid, c.G, (MP / 64) * 4, 0, lds); }
        { const Ctx c = mk(prm); dn_prep_rows(c, l); }
        xcd_barrier(xbar);
        { const Ctx c = mk(prm);
        if (c.bid < 32) {
            dn_chunk_scan(c, l, c.bid >> 2, c.bid & 3, lds);
        } else {
            const int nb = c.G - 32, ob = c.bid - 32;
            lru_items(c, l, ob, nb, (M / 64) * 4, 1, lds);
            for (int it = ob; it < SBATCH * 4; it += nb) { const int sb = it >> 2, h = it & 3; const size_t so = (size_t)((l * SBATCH + sb) * 4 + h) * 16384;
                dn_scan_item(c, l, MP + sb * 4, 4, h, prm.in[I_SDN] + so, prm.out + O_SDN + so, lds); }
        } }
        xcd_barrier(xbar);
        { const Ctx c = mk(prm); unsigned char* wb = wbuf(c, l);
          pg8::Gemm g{c.OAB, (const bf16_t*)(wb + WO_WAB), D, D, 512}; pg8::TwoHalfOrder S; S.init(M, D, c.G, c.bid);
          pg8::EpiMerge E{c.MERGED, c.PROJ};
          pg8::gemm_phase<pg8::EpiMerge, pg8::TwoHalfOrder, 1>(lds, g, S, E); }
        xcd_barrier(xbar);
        { const Ctx c = mk(prm); unsigned char* wb = wbuf(c, l);
          pg8::Gemm g{c.MERGED, (const bf16_t*)(wb + WO_WO), D, D, D}; pg8::StaticOrder S; S.init(M, D, c.G, c.bid);
          pg8::EpiResid E{c.XB, c.SSQ};
          pg8::gemm_phase<pg8::EpiResid, pg8::StaticOrder, 0>(lds, g, S, E); }
        xcd_barrier(xbar);
        { const Ctx c = mk(prm); unsigned char* wb = wbuf(c, l);
          pg8::Gemm g{c.XB, (const bf16_t*)(wb + WO_WFF), D, D, D}; pg8::StaticOrder S; S.init(M, 2 * DFF, c.G, c.bid);
          pg8::EpiScaleBf16 E{c.HB, 2 * DFF, c.SSQ};
          pg8::gemm_phase<pg8::EpiScaleBf16, pg8::StaticOrder, 0>(lds, g, S, E); }
        xcd_barrier(xbar);
        { const Ctx c = mk(prm); ffn_act(c, l); }
        xcd_barrier(xbar);
        { const Ctx c = mk(prm); unsigned char* wb = wbuf(c, l);
          pg8::Gemm g{c.HB + DFF, (const bf16_t*)(wb + WO_WDN), 2 * DFF, DFF, DFF}; pg8::StaticOrder S; S.init(MP, D, c.G, c.bid);
          pg8::EpiResid E{c.XB, c.SSQ};
          pg8::gemm_phase<pg8::EpiResid, pg8::StaticOrder, 0>(lds, g, S, E); }
        { const Ctx c = mk(prm); unsigned char* wb = wbuf(c, l);
          pg8::Gemm g{c.HB + DFF, (const bf16_t*)(wb + WO_WDN), 2 * DFF, DFF, 1024}; pg8::SampleSplitOrder S{c.G, c.bid};
          pg8::EpiPartial E{(float*)(c.ws + WS_Z)};
          pg8::gemm_phase<pg8::EpiPartial, pg8::SampleSplitOrder, 2>(lds, g, S, E);
          if (l + 1 < DEPTH && c.bid >= 24) convert_layer(c, l + 1, (c.bid - 24) * 8 + c.wave, (c.G - 24) * 8, lds); }
        xcd_barrier(xbar);
        { const Ctx c = mk(prm); sample_fixup(c); }
        xcd_barrier(xbar);
    }
    { const Ctx c = mk(prm); final_norm(c); }
}

extern "C" void kernel_launch(void* const* d_in, const int* in_sizes, int n_in, void* d_out, int out_size, void* d_ws, size_t ws_size, hipStream_t stream) {
    static int grid = 0;
    if (grid == 0) {
        if (n_in != 28 || (size_t)out_size != O_END || ws_size < WS_END) { fprintf(stderr, "kernel_launch: unexpected shapes n_in %d out %d ws %zu\n", n_in, out_size, ws_size); grid = -1; return; }
        int dev = 0, cus = 0, per_cu = 0;
        (void)hipGetDevice(&dev);
        (void)hipDeviceGetAttribute(&cus, hipDeviceAttributeMultiprocessorCount, dev);
        (void)hipFuncSetAttribute((const void*)mega, hipFuncAttributeMaxDynamicSharedMemorySize, LDS_BYTES);
        (void)hipOccupancyMaxActiveBlocksPerMultiprocessor(&per_cu, (const void*)mega, 512, LDS_BYTES);
        fprintf(stderr, "kernel_launch: cus %d per_cu %d ws %zu\n", cus, per_cu, ws_size);
        grid = cus;
    }
    if (grid < 0) return;
    (void)hipMemsetAsync(d_ws, 0, 16384, stream);
    Params p{};
    for (int i = 0; i < 28; ++i) p.in[i] = (const float*)d_in[i];
    p.out = (float*)d_out; p.ws = (unsigned char*)d_ws;
    void* args[] = {&p};
    hipError_t e = hipLaunchCooperativeKernel((const void*)mega, dim3(grid), dim3(512), args, LDS_BYTES, stream);
    if (e != hipSuccess) fprintf(stderr, "kernel_launch: cooperative launch failed: %s\n", hipGetErrorString(e));
}
```

```cpp
#include <hip/hip_runtime.h>
#include <hip/hip_cooperative_groups.h>
#include <cstdio>
#include <cstdint>
namespace cg = cooperative_groups;

#define LAS __attribute__((address_space(3)))
#define DEV __device__ __forceinline__
typedef unsigned short bf16_t;
typedef short bf16x8 __attribute__((ext_vector_type(8)));
typedef float f32x4 __attribute__((ext_vector_type(4)));
typedef float f32x2 __attribute__((ext_vector_type(2)));
typedef unsigned u32x4 __attribute__((ext_vector_type(4)));
typedef unsigned u32x2 __attribute__((ext_vector_type(2)));

constexpr int D = 1024, NBATCH = 8, SEQ = 2048, DEPTH = 4, SBATCH = 128, SSEQ = 4;
constexpr int MP = NBATCH * SEQ, MS = SBATCH * SSEQ, M = MP + MS;
constexpr int NPROJ = 5376;
constexpr int DFF = 3072;
constexpr int NSLOT = 16;
constexpr int C_QKV = 0, C_Z = 1536, C_LX = 2048, C_LY = 2560, C_GA = 3072, C_GB = 4096, C_AIN = 5120, C_BIN = 5124;
constexpr size_t O_YP = 0, O_YS = 16777216, O_PDC = 17301504, O_PDN = 17448960, O_PLC = 19546112, O_PL = 19595264, O_PFC = 19611648,
                 O_SDC = 19808256, O_SDN = 22167552, O_SLC = 55721984, O_SL = 56508416, O_SFC = 56770560, O_END = 59916288;
constexpr size_t MiB = 1u << 20;
constexpr size_t WS_SSQ = 1 * MiB, WS_GB = 3 * MiB, WS_WB = 4 * MiB, WB_STRIDE = 34 * MiB;
constexpr size_t WS_XF = 72 * MiB, WS_XB = 138 * MiB, WS_PROJ = 171 * MiB, WS_QKVN = 345 * MiB, WS_WP = 347 * MiB, WS_QGP = 363 * MiB, WS_KDP = 379 * MiB, WS_UTP = 395 * MiB, WS_ATP = 411 * MiB;
constexpr size_t WS_CSA = 419 * MiB, WS_CSH = 420 * MiB, WS_GL = 420 * MiB + 786432, WS_OAB = 421 * MiB;
constexpr size_t WS_MERGED = 347 * MiB, WS_HB = 171 * MiB, WS_Z = 454 * MiB, WS_RAWG = 460 * MiB, WS_RAWU = 467 * MiB, WS_END = 471 * MiB;
constexpr size_t WO_WIN = 0, WO_WAB = 11 * MiB, WO_WO = 13 * MiB, WO_WFF = 15 * MiB, WO_WDN = 27 * MiB, WO_LWA = 33 * MiB, WO_LWX = 33 * MiB + 131072;
constexpr int LDS_BYTES = 147456;

DEV float bf2f(unsigned short b) { return __uint_as_float(((unsigned)b) << 16); }
DEV unsigned f2bf(float f) { unsigned u = __float_as_uint(f); return (u + 0x7fffu + ((u >> 16) & 1u)) >> 16; }
DEV unsigned pk2(float lo, float hi) { return f2bf(lo) | (f2bf(hi) << 16); }
DEV float sigm(float x) { return 1.f / (1.f + __expf(-x)); }
DEV float siluf_(float x) { return x / (1.f + __expf(-x)); }
DEV float gelu_t(float x) { const float u = 1.5957691216f * (x + 0.044715f * x * x * x); return x / (1.f + __expf(-u)); }
DEV float neg_expm1(float x) {
    const float pz = x * (1.f + x * (0.5f + x * (0.16666667f + x * (0.041666668f + x * (0.0083333338f + x * 0.0013888889f)))));
    return x > -0.3f ? -pz : 1.f - __expf(x);
}
DEV float softplus_(float x) { return fmaxf(x, 0.f) + log1pf(__expf(-fabsf(x))); }
DEV float wave_sum(float v) {
#pragma unroll
    for (int o = 1; o < 64; o <<= 1) v += __shfl_xor(v, o);
    return v;
}
DEV void unpack8(const u32x4 w, float (&f)[8]) {
    f[0] = __uint_as_float(w.x << 16); f[1] = __uint_as_float(w.x & 0xffff0000u); f[2] = __uint_as_float(w.y << 16); f[3] = __uint_as_float(w.y & 0xffff0000u);
    f[4] = __uint_as_float(w.z << 16); f[5] = __uint_as_float(w.z & 0xffff0000u); f[6] = __uint_as_float(w.w << 16); f[7] = __uint_as_float(w.w & 0xffff0000u);
}
DEV u32x4 pack8(const float (&f)[8]) { u32x4 w; w.x = pk2(f[0], f[1]); w.y = pk2(f[2], f[3]); w.z = pk2(f[4], f[5]); w.w = pk2(f[6], f[7]); return w; }

struct Params { const float* in[28]; float* out; unsigned char* ws; };
enum { I_XP = 0, I_XS, I_SDC, I_SDN, I_SLC, I_SL, I_SFC, I_N1, I_WIN, I_DCW, I_ALOG, I_DTB, I_DNW, I_LCW, I_LCB, I_LWA, I_LBA, I_LWX, I_LBX, I_LAM, I_WBA, I_WBB, I_WO, I_N2, I_WFF, I_FCW, I_WDN, I_FNW };

namespace pg8 {
constexpr int BM = 256, BK = 64, HALF = 128, HTB = HALF * BK * 2, STAGE_BYTES = 8 * HTB, NXCD = 8, WGM = 8;
__host__ __device__ __forceinline__ int lds_byte(int r, int c) { const int st = (r >> 4) * 2 + (c >> 5), rr = r & 15, cc = c & 31, ob = rr * 64 + cc * 2; return st * 1024 + (ob ^ (((ob >> 9) & 1) << 5)); }
__host__ __device__ __forceinline__ void stage_rc(int b, int& R, int& C) { const int st = b / 1024, sb = b % 1024, swz = sb ^ (((sb >> 9) & 1) << 5); R = (st >> 1) * 16 + swz / 64; C = (st & 1) * 32 + (swz % 64) / 2; }
__host__ __device__ __forceinline__ int perm32(int rho) { const int n = rho >> 4, i = rho & 15; return 8 * (i >> 2) + 4 * n + (i & 3); }
struct Unit { int pm, pn, kh; };
struct Gemm { const bf16_t* A; const bf16_t* Bt; int lda, ldb, K; };
struct StaticOrder {
    int nM, nN, nwg, G, c;
    __device__ void init(int M_, int N_, int G_, int c_) { nM = M_ / BM; nN = N_ / BM; nwg = nM * nN; G = G_; c = c_; }
    __device__ bool next(int i, Unit& u) const {
        const long L = (long)i * G + c; if (L >= nwg) return false;
        int wgid = (int)L; { const int q = nwg / NXCD, r = nwg % NXCD, xcd = wgid % NXCD, off = wgid / NXCD; wgid = (xcd < r ? xcd * (q + 1) : r * (q + 1) + (xcd - r) * q) + off; }
        const int nig = WGM * nN, gid = wgid / nig, fm = gid * WGM, gsz = (nM - fm) < WGM ? (nM - fm) : WGM;
        u.pm = fm + ((wgid % nig) % gsz); u.pn = (wgid % nig) / gsz; u.kh = 0; return true;
    }
};
struct TwoHalfOrder : StaticOrder {
    __device__ bool next(int i, Unit& u) const { if (!StaticOrder::next(i >> 1, u)) return false; u.kh = i & 1; return true; }
};
struct SampleSplitOrder {
    int G, c;
    __device__ bool next(int i, Unit& u) const { const int L = i * G + c; if (L >= 24) return false; const int rem = L % 12; u.pm = MP / BM + L / 12; u.pn = rem / 3; u.kh = rem % 3; return true; }
};
DEV unsigned cvt_pk_bf16(float lo, float hi) { unsigned r; asm volatile("v_cvt_pk_bf16_f32 %0, %1, %2" : "=v"(r) : "v"(lo), "v"(hi)); return r; }

template <class Epi, class Sched, int MODE>
DEV void gemm_phase(LAS unsigned char* lds, const Gemm g, const Sched& S, const Epi& E) {
    int tid = threadIdx.x; asm volatile("" : "+v"(tid));
    const int wid = __builtin_amdgcn_readfirstlane(tid >> 6), lane = tid & 63, wr = wid >> 2, wc = wid & 3, fr = lane & 15, fq = lane >> 4;
    const int K = g.K, nt = K / BK;
    unsigned voffA[2], voffB[2];
#pragma unroll
    for (int i = 0; i < 2; ++i) { int R, C; stage_rc(tid * 16 + i * 8192, R, C); const int Rb = Epi::PERM ? ((R & ~31) + perm32(R & 31)) : R;
        voffA[i] = (unsigned)(R * g.lda + C) * 2u; voffB[i] = (unsigned)(Rb * g.ldb + C) * 2u; }
    const size_t kstep = (size_t)(BK * 2);
    const size_t hstepA = (size_t)HALF * g.lda * 2, hstepB = (size_t)HALF * g.ldb * 2;
    const size_t tstepA = 2 * hstepA, tstepB = 2 * hstepB;
    const unsigned ldsw = (unsigned)wid * 1024u;
    const int aoff = lds_byte(wr * 64 + fr, fq * 8), boff = lds_byte(wc * 32 + fr, fq * 8);
#define PG8_SA(b, h) (((b) * 2 + (h)) * HTB)
#define PG8_SB(b, h) ((4 + (b) * 2 + (h)) * HTB)
#define PG8_STAGE(bufoff, gbase, voff) do { _Pragma("unroll") for (int _i = 0; _i < 2; ++_i) \
        __builtin_amdgcn_global_load_lds((const unsigned*)((const char*)(gbase) + (voff)[_i]), (LAS unsigned*)(lds + (bufoff) + ldsw + _i * 8192), 16, 0, 0); } while (0)
#define PG8_LDA(dst, b, h) do { _Pragma("unroll") for (int m = 0; m < 4; ++m) _Pragma("unroll") for (int k = 0; k < 2; ++k) dst[m][k] = *(const LAS bf16x8*)(lds + PG8_SA(b, h) + aoff + m * 2048 + k * 1024); } while (0)
#define PG8_LDB(dst, b, h) do { _Pragma("unroll") for (int n = 0; n < 2; ++n) _Pragma("unroll") for (int k = 0; k < 2; ++k) dst[n][k] = *(const LAS bf16x8*)(lds + PG8_SB(b, h) + boff + n * 2048 + k * 1024); } while (0)
#define PG8_MMA(ai, bj, At, Bt) do { __builtin_amdgcn_s_setprio(1); _Pragma("unroll") for (int m = 0; m < 4; ++m) _Pragma("unroll") for (int n = 0; n < 2; ++n) _Pragma("unroll") for (int k = 0; k < 2; ++k) \
        acc[ai][bj][m][n] = __builtin_amdgcn_mfma_f32_16x16x32_bf16(Bt[n][k], At[m][k], acc[ai][bj][m][n], 0, 0, 0); __builtin_amdgcn_s_setprio(0); } while (0)
#define PG8_WAIT_V(n) asm volatile("s_waitcnt vmcnt(" #n ")" ::: "memory")
#define PG8_WAIT_L(n) asm volatile("s_waitcnt lgkmcnt(" #n ")" ::: "memory")
#define PG8_BAR __builtin_amdgcn_s_barrier()
#define PG8_SCHED __builtin_amdgcn_sched_barrier(0)
    Unit cur, nxt; int ui = 0;
    if (!S.next(0, cur)) return;
    f32x4 acc[2][2][4][2];
#pragma unroll
    for (int a = 0; a < 2; ++a)
#pragma unroll
        for (int b = 0; b < 2; ++b)
#pragma unroll
            for (int m = 0; m < 4; ++m)
#pragma unroll
                for (int n = 0; n < 2; ++n) acc[a][b][m][n] = (f32x4){0.f, 0.f, 0.f, 0.f};
    bf16x8 At[4][2], B0[2][2], B1[2][2];
    const size_t khstep = MODE ? (size_t)K * 2 : 0;
    const char* cA = (const char*)g.A + (size_t)cur.pm * tstepA + cur.kh * khstep; const char* cB = (const char*)g.Bt + (size_t)cur.pn * tstepB + cur.kh * khstep;
    PG8_STAGE(PG8_SB(0, 0), cB, voffB); PG8_STAGE(PG8_SB(0, 1), cB + hstepB, voffB); PG8_STAGE(PG8_SA(0, 0), cA, voffA); PG8_STAGE(PG8_SA(0, 1), cA + hstepA, voffA);
    if (wr == 1) PG8_BAR;
    PG8_WAIT_V(2); PG8_BAR;
    PG8_STAGE(PG8_SB(1, 0), cB + kstep, voffB); PG8_STAGE(PG8_SA(1, 0), cA + kstep, voffA); PG8_STAGE(PG8_SB(1, 1), cB + hstepB + kstep, voffB);
    PG8_WAIT_V(6); PG8_BAR;
    for (;;) {
        const bool has_next = S.next(ui + 1, nxt);
        const char* nA = has_next ? (const char*)g.A + (size_t)nxt.pm * tstepA + nxt.kh * khstep : cA; const char* nB = has_next ? (const char*)g.Bt + (size_t)nxt.pn * tstepB + nxt.kh * khstep : cB;
        for (int t = 0; t < nt; t += 2) {
            const bool last = (t == nt - 2);
            const char* a1 = cA + (size_t)(t + 1) * kstep;
            const char* a2 = last ? nA : cA + (size_t)(t + 2) * kstep; const char* b2 = last ? nB : cB + (size_t)(t + 2) * kstep;
            const char* a3 = a2 + kstep; const char* b3 = b2 + kstep;
            PG8_LDB(B0, 0, 0); PG8_LDB(B1, 0, 1); PG8_SCHED; PG8_LDA(At, 0, 0); PG8_STAGE(PG8_SA(1, 1), a1 + hstepA, voffA);
            PG8_WAIT_V(8); PG8_WAIT_L(0); PG8_BAR; PG8_MMA(0, 0, At, B0); PG8_MMA(0, 1, At, B1); PG8_BAR; PG8_SCHED;
            PG8_LDA(At, 0, 1); PG8_STAGE(PG8_SB(0, 0), b2, voffB); PG8_STAGE(PG8_SB(0, 1), b2 + hstepB, voffB); PG8_STAGE(PG8_SA(0, 0), a2, voffA);
            PG8_WAIT_V(8); PG8_WAIT_L(0); PG8_BAR; PG8_MMA(1, 0, At, B0); PG8_MMA(1, 1, At, B1); PG8_BAR; PG8_SCHED;
            PG8_LDB(B0, 1, 0); PG8_LDB(B1, 1, 1); PG8_SCHED; PG8_LDA(At, 1, 0); PG8_STAGE(PG8_SA(0, 1), a2 + hstepA, voffA);
            PG8_WAIT_V(8); PG8_WAIT_L(0); PG8_BAR; PG8_MMA(0, 0, At, B0); PG8_MMA(0, 1, At, B1); PG8_BAR; PG8_SCHED;
            PG8_LDA(At, 1, 1); PG8_STAGE(PG8_SB(1, 0), b3, voffB); PG8_STAGE(PG8_SB(1, 1), b3 + hstepB, voffB); PG8_STAGE(PG8_SA(1, 0), a3, voffA);
            PG8_WAIT_V(8); PG8_WAIT_L(0); PG8_BAR; PG8_MMA(1, 0, At, B0); PG8_MMA(1, 1, At, B1); PG8_BAR; PG8_SCHED;
        }
        if (wr == 0) PG8_BAR;
        E(acc, cur, wr, wc, fr, fq);
        if (!has_next) break;
        if (!(MODE == 1 && cur.kh == 0)) {
#pragma unroll
        for (int a = 0; a < 2; ++a)
#pragma unroll
            for (int b = 0; b < 2; ++b)
#pragma unroll
                for (int m = 0; m < 4; ++m)
#pragma unroll
                    for (int n = 0; n < 2; ++n) acc[a][b][m][n] = (f32x4){0.f, 0.f, 0.f, 0.f};
        }
        cur = nxt; cA = nA; cB = nB; ++ui;
        if (wr == 1) PG8_BAR;
    }
    PG8_WAIT_V(0);
    PG8_BAR;
#undef PG8_SA
#undef PG8_SB
#undef PG8_STAGE
#undef PG8_LDA
#undef PG8_LDB
#undef PG8_MMA
#undef PG8_WAIT_V
#undef PG8_WAIT_L
#undef PG8_BAR
#undef PG8_SCHED
}

struct EpiScaleBf16 {
    static constexpr bool PERM = true;
    bf16_t* O; int ldc; const float* ssq;
    DEV void operator()(const f32x4 (&acc)[2][2][4][2], const Unit& u, int wr, int wc, int fr, int fq) const {
        const int row0 = u.pm * BM + wr * 64 + fr, col0 = u.pn * BM + wc * 32 + 8 * fq;
#pragma unroll
        for (int ai = 0; ai < 2; ++ai) {
            f32x4 sv[4][4];
#pragma unroll
            for (int i = 0; i < 4; ++i)
#pragma unroll
                for (int k = 0; k < 4; ++k) sv[i][k] = *(const f32x4*)(ssq + (size_t)(row0 + ai * HALF + i * 16) * NSLOT + 4 * k);
#pragma unroll
            for (int m = 0; m < 4; ++m) {
                const int row = row0 + ai * HALF + m * 16;
                const f32x4 s4 = (sv[m][0] + sv[m][1]) + (sv[m][2] + sv[m][3]);
                const float s = (s4[0] + s4[1]) + (s4[2] + s4[3]);
                const float rs = rsqrtf(s * (1.f / 1024.f) + 1e-6f);
                bf16_t* rowp = O + (size_t)row * ldc + col0;
#pragma unroll
                for (int bj = 0; bj < 2; ++bj) { const f32x4 v0 = acc[ai][bj][m][0] * rs, v1 = acc[ai][bj][m][1] * rs;
                    u32x4 w; w.x = cvt_pk_bf16(v0[0], v0[1]); w.y = cvt_pk_bf16(v0[2], v0[3]); w.z = cvt_pk_bf16(v1[0], v1[1]); w.w = cvt_pk_bf16(v1[2], v1[3]);
                    *(u32x4*)(rowp + bj * HALF) = w; }
            }
        }
    }
};
struct EpiMerge {
    static constexpr bool PERM = true;
    bf16_t* O; const bf16_t* P;
    DEV void mid(f32x4 (&acc)[2][2][4][2], const Unit& u, int wr, int wc, int fr, int fq) const {
        const int row0 = u.pm * BM + wr * 64 + fr, col0 = u.pn * BM + wc * 32 + 8 * fq;
#pragma unroll
        for (int ai = 0; ai < 2; ++ai)
#pragma unroll
            for (int m = 0; m < 4; ++m) {
                const bf16_t* rowp = P + (size_t)(row0 + ai * HALF + m * 16) * NPROJ + col0;
#pragma unroll
                for (int bj = 0; bj < 2; ++bj) {
                    float ga[8], gb[8]; unpack8(*(const u32x4*)(rowp + C_GA + bj * HALF), ga); unpack8(*(const u32x4*)(rowp + C_GB + bj * HALF), gb);
#pragma unroll
                    for (int e = 0; e < 8; ++e) { const float ratio = (1.f + __expf(-gb[e])) / (1.f + __expf(-ga[e])); acc[ai][bj][m][e >> 2][e & 3] *= ratio; }
                    asm volatile("" ::: "memory");
                }
            }
    }
    DEV void operator()(f32x4 (&acc)[2][2][4][2], const Unit& u, int wr, int wc, int fr, int fq) const {
        if (u.kh == 0) { mid(acc, u, wr, wc, fr, fq); return; }
        const int row0 = u.pm * BM + wr * 64 + fr, col0 = u.pn * BM + wc * 32 + 8 * fq;
#pragma unroll
        for (int ai = 0; ai < 2; ++ai)
#pragma unroll
            for (int m = 0; m < 4; ++m) {
                const int row = row0 + ai * HALF + m * 16;
                const bf16_t* rowp = P + (size_t)row * NPROJ + col0;
#pragma unroll
                for (int bj = 0; bj < 2; ++bj) {
                    float gb[8]; unpack8(*(const u32x4*)(rowp + C_GB + bj * HALF), gb);
                    float o[8];
#pragma unroll
                    for (int e = 0; e < 8; ++e) o[e] = acc[ai][bj][m][e >> 2][e & 3] / (1.f + __expf(-gb[e]));
                    u32x4 w; w.x = cvt_pk_bf16(o[0], o[1]); w.y = cvt_pk_bf16(o[2], o[3]); w.z = cvt_pk_bf16(o[4], o[5]); w.w = cvt_pk_bf16(o[6], o[7]);
                    *(u32x4*)(O + (size_t)row * D + col0 + bj * HALF) = w;
                }
            }
    }
};
struct EpiResid {
    static constexpr bool PERM = false;
    bf16_t* XB; float* ssq;
    DEV void operator()(const f32x4 (&acc)[2][2][4][2], const Unit& u, int wr, int wc, int fr, int fq) const {
        const int row0 = u.pm * BM + wr * 64 + fr, col0 = u.pn * BM + wc * 32 + 4 * fq;
#pragma unroll
        for (int ai = 0; ai < 2; ++ai) {
            u32x2 xin[4][2][2];
#pragma unroll
            for (int m = 0; m < 4; ++m)
#pragma unroll
                for (int bj = 0; bj < 2; ++bj)
#pragma unroll
                    for (int n = 0; n < 2; ++n) xin[m][bj][n] = *(const u32x2*)(XB + (size_t)(row0 + ai * HALF + m * 16) * D + col0 + bj * HALF + n * 16);
#pragma unroll
            for (int m = 0; m < 4; ++m) {
                const int row = row0 + ai * HALF + m * 16;
                bf16_t* br = XB + (size_t)row * D + col0;
                float ss = 0.f;
#pragma unroll
                for (int bj = 0; bj < 2; ++bj)
#pragma unroll
                    for (int n = 0; n < 2; ++n) {
                        const u32x2 xi = xin[m][bj][n];
                        const float x0 = __uint_as_float(xi.x << 16) + acc[ai][bj][m][n][0], x1 = __uint_as_float(xi.x & 0xffff0000u) + acc[ai][bj][m][n][1];
                        const float x2 = __uint_as_float(xi.y << 16) + acc[ai][bj][m][n][2], x3 = __uint_as_float(xi.y & 0xffff0000u) + acc[ai][bj][m][n][3];
                        u32x2 w; w.x = cvt_pk_bf16(x0, x1); w.y = cvt_pk_bf16(x2, x3); *(u32x2*)(br + bj * HALF + n * 16) = w;
                        const float r0 = __uint_as_float(w.x << 16), r1 = __uint_as_float(w.x & 0xffff0000u), r2 = __uint_as_float(w.y << 16), r3 = __uint_as_float(w.y & 0xffff0000u);
                        ss += (r0 * r0 + r1 * r1) + (r2 * r2 + r3 * r3);
                    }
                ss += __shfl_xor(ss, 16); ss += __shfl_xor(ss, 32);
                if (fq == 0) ssq[(size_t)row * NSLOT + u.pn * 4 + wc] = ss;
            }
        }
    }
};
DEV float dpp_ror1(float v) { return __int_as_float(__builtin_amdgcn_update_dpp(0, __float_as_int(v), 0x121, 0xf, 0xf, false)); }
DEV float dpp_ror2(float v) { return __int_as_float(__builtin_amdgcn_update_dpp(0, __float_as_int(v), 0x122, 0xf, 0xf, false)); }
struct EpiAct {
    static constexpr bool PERM = true;
    bf16_t* ACT; const float* ssq; bf16_t* RAWG; bf16_t* RAWU; const float* cw; const float* st; float* outS;
    DEV void operator()(const f32x4 (&acc)[2][2][4][2], const Unit& u, int wr, int wc, int fr_in, int fq_in) const {
        int fr = fr_in, fq = fq_in; asm volatile("" : "+v"(fr), "+v"(fq));
        const int row0 = u.pm * BM + wr * 64 + fr, f0 = u.pn * HALF + wc * 32 + 8 * fq;
        const bool sample = u.pm >= MP / BM;
        float w0[8], w1[8], w2[8];
#pragma unroll
        for (int ai = 0; ai < 2; ++ai) {
            float rs[4];
#pragma unroll
            for (int hm = 0; hm < 2; ++hm) {
                f32x4 sv[2][4];
#pragma unroll
                for (int i = 0; i < 2; ++i)
#pragma unroll
                    for (int k = 0; k < 4; ++k) sv[i][k] = *(const f32x4*)(ssq + (size_t)(row0 + ai * HALF + (2 * hm + i) * 16) * NSLOT + 4 * k);
#pragma unroll
                for (int i = 0; i < 2; ++i) { const f32x4 s4 = (sv[i][0] + sv[i][1]) + (sv[i][2] + sv[i][3]); rs[2 * hm + i] = rsqrtf(((s4[0] + s4[1]) + (s4[2] + s4[3])) * (1.f / 1024.f) + 1e-6f); }
                __builtin_amdgcn_sched_barrier(0);
            }
            if (ai == 0) { const f32x4 a0 = *(const f32x4*)(cw + f0), a1 = *(const f32x4*)(cw + f0 + 4), b0 = *(const f32x4*)(cw + DFF + f0), b1 = *(const f32x4*)(cw + DFF + f0 + 4), c0 = *(const f32x4*)(cw + 2 * DFF + f0), c1 = *(const f32x4*)(cw + 2 * DFF + f0 + 4);
#pragma unroll
                for (int e = 0; e < 4; ++e) { w0[e] = a0[e]; w0[e + 4] = a1[e]; w1[e] = b0[e]; w1[e + 4] = b1[e]; w2[e] = c0[e]; w2[e + 4] = c1[e]; } }
            float p1[8], p2[8];
#pragma unroll
            for (int e = 0; e < 8; ++e) { p1[e] = 0.f; p2[e] = 0.f; }
#pragma unroll
            for (int m = 0; m < 4; ++m) {
                const int row = row0 + ai * HALF + m * 16;
                const int pos = fr & 3, sb = (row - MP) >> 2;
                u32x2 pkA[2], pkG[2], pkU[2];
#pragma unroll
                for (int hh = 0; hh < 2; ++hh) {
                    float gm[4], g1[4], g2[4], a[4], upv[4];
#pragma unroll
                    for (int e4 = 0; e4 < 4; ++e4) {
                        const int e = 4 * hh + e4;
                        gm[e4] = acc[ai][0][m][hh][e4] * rs[m];
                        const float r1c = dpp_ror1(gm[e4]), r2c = dpp_ror2(gm[e4]);
                        g1[e4] = fr >= 1 ? r1c : p1[e]; g2[e4] = fr >= 2 ? r2c : p2[e];
                        p1[e] = r1c; p2[e] = r2c;
                    }
                    if (sample) {
                        if (pos < 2) {
                            const f32x4 pp = *(const f32x4*)(st + (size_t)(sb * 2) * DFF + f0 + 4 * hh), qq = *(const f32x4*)(st + (size_t)(sb * 2 + 1) * DFF + f0 + 4 * hh);
#pragma unroll
                            for (int e4 = 0; e4 < 4; ++e4) { if (pos == 0) { g1[e4] = qq[e4]; g2[e4] = pp[e4]; } else g2[e4] = qq[e4]; }
                        } else *(f32x4*)(outS + (size_t)(sb * 2 + (pos - 2)) * DFF + f0 + 4 * hh) = (f32x4){gm[0], gm[1], gm[2], gm[3]};
                    }
#pragma unroll
                    for (int e4 = 0; e4 < 4; ++e4) { const int e = 4 * hh + e4; upv[e4] = acc[ai][1][m][hh][e4] * rs[m]; a[e4] = gelu_t(w0[e] * g2[e4] + w1[e] * g1[e4] + w2[e] * gm[e4]) * upv[e4]; }
                    pkA[hh].x = cvt_pk_bf16(a[0], a[1]); pkA[hh].y = cvt_pk_bf16(a[2], a[3]);
                    pkG[hh].x = cvt_pk_bf16(gm[0], gm[1]); pkG[hh].y = cvt_pk_bf16(gm[2], gm[3]);
                    pkU[hh].x = cvt_pk_bf16(upv[0], upv[1]); pkU[hh].y = cvt_pk_bf16(upv[2], upv[3]);
                    __builtin_amdgcn_sched_barrier(0);
                }
                const u32x4 wa = {pkA[0].x, pkA[0].y, pkA[1].x, pkA[1].y}, wg = {pkG[0].x, pkG[0].y, pkG[1].x, pkG[1].y}, wu = {pkU[0].x, pkU[0].y, pkU[1].x, pkU[1].y};
                const bool fix = !sample && m == 0 && fr < 2;
                if (fix) { *(u32x4*)(RAWG + (size_t)((row >> 6) * 4 + fr) * DFF + f0) = wg; *(u32x4*)(RAWU + (size_t)((row >> 6) * 2 + fr) * DFF + f0) = wu; }
                else *(u32x4*)(ACT + (size_t)row * DFF + f0) = wa;
                if (!sample && m == 3 && fr >= 14) *(u32x4*)(RAWG + (size_t)((row >> 6) * 4 + 2 + (fr - 14)) * DFF + f0) = wg;
                __builtin_amdgcn_sched_barrier(0);
            }
        }
    }
};
struct EpiPartial {
    static constexpr bool PERM = false;
    float* Z;
    DEV void operator()(const f32x4 (&acc)[2][2][4][2], const Unit& u, int wr, int wc, int fr, int fq) const {
        const int row0 = u.pm * BM - MP + wr * 64 + fr, col0 = u.pn * BM + wc * 32 + 4 * fq;
        float* zb = Z + (size_t)u.kh * MS * D;
#pragma unroll
        for (int ai = 0; ai < 2; ++ai)
#pragma unroll
            for (int m = 0; m < 4; ++m)
#pragma unroll
                for (int bj = 0; bj < 2; ++bj)
#pragma unroll
                    for (int n = 0; n < 2; ++n) *(f32x4*)(zb + (size_t)(row0 + ai * HALF + m * 16) * D + col0 + bj * HALF + n * 16) = acc[ai][bj][m][n];
    }
};
}

#define XB_TMO      128
#define XB_XCNT(j)  (256  + 64 * (j))
#define XB_XSUB(j)  (1280 + 64 * (j))
#define XB_XGEN(j)  (2304 + 64 * (j))
#define XB_TOP      3328
#define XB_TOPGEN   3392
#define XCD_BAR_WORDS 3456
#define XB_SPIN_CAP (1u << 20)
DEV unsigned xb_ld(unsigned* p)              { return __hip_atomic_load(p, __ATOMIC_RELAXED, __HIP_MEMORY_SCOPE_AGENT); }
DEV unsigned xb_add(unsigned* p, unsigned v) { return __hip_atomic_fetch_add(p, v, __ATOMIC_RELAXED, __HIP_MEMORY_SCOPE_AGENT); }
DEV unsigned xb_xcc_id() { return (unsigned)__builtin_amdgcn_s_getreg((3 << 11) | 20) & 0xFu; }
#define XB_SPIN(cond, bar) do { unsigned _sp = 0; while (cond) { __builtin_amdgcn_s_sleep(1); \
    if ((++_sp & 255u) == 0u) { if (xb_ld(&(bar)[XB_TMO])) break; if (_sp > XB_SPIN_CAP) { atomicAdd(&(bar)[XB_TMO], 1u); break; } } } } while (0)
struct XcdBarrier { unsigned* bar; unsigned x; volatile LAS unsigned* st; };
DEV XcdBarrier xcd_barrier_post(unsigned* bar, volatile LAS unsigned* st) {
    XcdBarrier b; b.bar = bar; b.x = xb_xcc_id(); b.st = st;
    if (threadIdx.x == 0) (void)xb_add(&bar[XB_XCNT(b.x)], 1u);
    return b;
}
DEV void xcd_barrier_complete(unsigned* bar, unsigned x, unsigned& nloc, unsigned& nx) {
    const unsigned G = gridDim.x * gridDim.y * gridDim.z;
    unsigned sum, cnt, mine, sp = 0u;
    for (;;) {
        sum = 0u; cnt = 0u; mine = 0u;
#pragma unroll
        for (unsigned j = 0; j < 16; ++j) { const unsigned c = xb_ld(&bar[XB_XCNT(j)]); sum += c; cnt += (c > 0u) ? 1u : 0u; mine = (j == x) ? c : mine; }
        if (sum == G) break;
        __builtin_amdgcn_s_sleep(1);
        if ((++sp & 255u) == 0u) { if (xb_ld(&bar[XB_TMO])) break; if (sp > XB_SPIN_CAP) { atomicAdd(&bar[XB_TMO], 1u); break; } }
    }
    nloc = mine > 0u ? mine : 1u; nx = cnt > 0u ? cnt : 1u;
}
DEV void xcd_barrier(const XcdBarrier& b) {
    asm volatile("s_waitcnt vmcnt(0)" ::: "memory");
    __syncthreads();
    if (threadIdx.x == 0) {
        unsigned* bar = b.bar;
        __builtin_amdgcn_s_waitcnt(0);
        unsigned nloc = b.st[0], nx = b.st[1];
        if (nloc == 0u) { xcd_barrier_complete(bar, b.x, nloc, nx); b.st[0] = nloc; b.st[1] = nx; }
        const unsigned old = xb_add(&bar[XB_XSUB(b.x)], 1u);
        const unsigned gen = old / nloc;
        if (old + 1u == (gen + 1u) * nloc) {
            __builtin_amdgcn_fence(__ATOMIC_RELEASE, "agent");
            asm volatile("s_waitcnt vmcnt(0)" ::: "memory");
            const unsigned og = xb_add(&bar[XB_TOP], 1u);
            const unsigned tg = og / nx;
            if (og + 1u == (tg + 1u) * nx) xb_add(&bar[XB_TOPGEN], 1u);
            else XB_SPIN(xb_ld(&bar[XB_TOPGEN]) == tg, bar);
            __builtin_amdgcn_fence(__ATOMIC_ACQUIRE, "agent");
            xb_add(&bar[XB_XGEN(b.x)], 1u);
            asm volatile("s_waitcnt vmcnt(0)" ::: "memory");
        } else {
            XB_SPIN(xb_ld(&bar[XB_XGEN(b.x)]) == gen, bar);
            __builtin_amdgcn_fence(__ATOMIC_ACQUIRE, "agent");
            asm volatile("s_waitcnt vmcnt(0)" ::: "memory");
        }
    }
    __syncthreads();
}

struct Ctx {
    const Params* p;
    unsigned char* ws;
    float* SSQ; float* GB; float* XF; bf16_t* XB; bf16_t* PROJ; bf16_t* QKVN; bf16_t* OAB; bf16_t* MERGED; bf16_t* HB;
    bf16_t *WP, *QGP, *KDP, *UTP, *ATP; float *CSA, *CSH, *GL;
    int tid, lane, wave, G, bid;
};
DEV unsigned char* wbuf(const Ctx& c, int l) { return c.ws + WS_WB + (size_t)(l & 1) * WB_STRIDE; }
DEV Ctx mk(const Params& prm) {
    Ctx c; c.p = &prm;
    size_t zoff = 0; asm volatile("" : "+s"(zoff)); unsigned char* w = prm.ws + zoff; c.ws = w;
    c.SSQ = (float*)(w + WS_SSQ); c.GB = (float*)(w + WS_GB); c.XF = (float*)(w + WS_XF); c.XB = (bf16_t*)(w + WS_XB);
    c.PROJ = (bf16_t*)(w + WS_PROJ); c.QKVN = (bf16_t*)(w + WS_QKVN);
    c.WP = (bf16_t*)(w + WS_WP); c.QGP = (bf16_t*)(w + WS_QGP); c.KDP = (bf16_t*)(w + WS_KDP); c.UTP = (bf16_t*)(w + WS_UTP); c.ATP = (bf16_t*)(w + WS_ATP);
    c.CSA = (float*)(w + WS_CSA); c.CSH = (float*)(w + WS_CSH); c.GL = (float*)(w + WS_GL);
    c.OAB = (bf16_t*)(w + WS_OAB); c.MERGED = (bf16_t*)(w + WS_MERGED); c.HB = (bf16_t*)(w + WS_HB);
    int tid = threadIdx.x; asm volatile("" : "+v"(tid));
    c.tid = tid; c.lane = tid & 63; c.wave = __builtin_amdgcn_readfirstlane(tid >> 6); c.G = gridDim.x; c.bid = blockIdx.x;
    return c;
}

DEV void tr_item(const float* W, int Nsrc, const float* kscale, bf16_t* WT, int ldk, int k0, int n0, int mode, LAS float* scr, int lane) {
    const int n = n0 + (lane & 31);
    int src = n;
    if (mode == 1) src = (n < 2048) ? n : (n < 5120 ? n + 8 : (n < 5128 ? n - 5120 + 2048 : -1));
    if (mode == 2) src = ((n >> 7) & 1) * DFF + (n >> 8) * 128 + (n & 127);
#pragma unroll 8
    for (int i = 0; i < 32; ++i) { const int kk = 2 * i + (lane >> 5); float v = 0.f;
        if (src >= 0) v = W[(size_t)(k0 + kk) * Nsrc + src];
        if (kscale) v *= kscale[k0 + kk];
        scr[kk * 33 + (lane & 31)] = v; }
    asm volatile("s_waitcnt lgkmcnt(0)" ::: "memory");
    const int cch = lane & 7;
#pragma unroll
    for (int j = 0; j < 4; ++j) { const int nn = (lane >> 3) + 8 * j; const LAS float* s = scr + (8 * cch) * 33 + nn;
        u32x4 o; o.x = pk2(s[0 * 33], s[1 * 33]); o.y = pk2(s[2 * 33], s[3 * 33]); o.z = pk2(s[4 * 33], s[5 * 33]); o.w = pk2(s[6 * 33], s[7 * 33]);
        *(u32x4*)(WT + (size_t)(n0 + nn) * ldk + k0 + 8 * cch) = o; }
    asm volatile("s_waitcnt lgkmcnt(0)" ::: "memory");
}
DEV void convert_layer(const Ctx& c, int l, int w, int nw, LAS unsigned char* lds) {
    LAS float* scr = (LAS float*)(lds + c.wave * 16384);
    unsigned char* wb = wbuf(c, l);
    const Params& p = *c.p;
    constexpr int I_IN = 16 * (NPROJ / 32), I_AB = 8 * 32, I_O = 16 * 32, I_FF = 16 * (2 * DFF / 32), I_DN = (DFF / 64) * 32, I_L = 2 * 4;
    constexpr int TOT = I_IN + 2 * I_AB + I_O + I_FF + I_DN + 8 * I_L;
    for (int it = w; it < TOT; it += nw) {
        int r = it;
        if (r < I_IN) { const int nb = NPROJ / 32; tr_item(p.in[I_WIN] + (size_t)l * D * 5128, 5128, p.in[I_N1] + l * D, (bf16_t*)(wb + WO_WIN), D, 64 * (r / nb), 32 * (r % nb), 1, scr, c.lane); continue; } r -= I_IN;
        if (r < I_AB) { tr_item(p.in[I_WBA] + (size_t)l * 512 * D, D, nullptr, (bf16_t*)(wb + WO_WAB), D, 64 * (r / 32), 32 * (r % 32), 0, scr, c.lane); continue; } r -= I_AB;
        if (r < I_AB) { tr_item(p.in[I_WBB] + (size_t)l * 512 * D, D, nullptr, (bf16_t*)(wb + WO_WAB) + 512, D, 64 * (r / 32), 32 * (r % 32), 0, scr, c.lane); continue; } r -= I_AB;
        if (r < I_O) { tr_item(p.in[I_WO] + (size_t)l * D * D, D, nullptr, (bf16_t*)(wb + WO_WO), D, 64 * (r / 32), 32 * (r % 32), 0, scr, c.lane); continue; } r -= I_O;
        if (r < I_FF) { const int nb = 2 * DFF / 32; tr_item(p.in[I_WFF] + (size_t)l * D * 2 * DFF, 2 * DFF, p.in[I_N2] + l * D, (bf16_t*)(wb + WO_WFF), D, 64 * (r / nb), 32 * (r % nb), 2, scr, c.lane); continue; } r -= I_FF;
        if (r < I_DN) { tr_item(p.in[I_WDN] + (size_t)l * DFF * D, D, nullptr, (bf16_t*)(wb + WO_WDN), DFF, 64 * (r / 32), 32 * (r % 32), 0, scr, c.lane); continue; } r -= I_DN;
        { const int mat = r / I_L, rr = r % I_L, blk = mat & 3, which = mat >> 2;
          const float* W = (which ? p.in[I_LWX] : p.in[I_LWA]) + (size_t)(l * 4 + blk) * 16384;
          bf16_t* WT = (bf16_t*)(wb + (which ? WO_LWX : WO_LWA)) + blk * 16384;
          tr_item(W, 128, nullptr, WT, 128, 64 * (rr / 4), 32 * (rr % 4), 0, scr, c.lane); }
    }
}

DEV void x_prologue(const Ctx& c) {
    const int gw = c.bid * 8 + c.wave, NGW = c.G * 8;
    for (int row = gw; row < M; row += NGW) {
        const float* src = row < MP ? c.p->in[I_XP] + (size_t)row * D : c.p->in[I_XS] + (size_t)(row - MP) * D;
        float ss = 0.f;
#pragma unroll
        for (int j = 0; j < 4; ++j) { const f32x4 v = *(const f32x4*)(src + j * 256 + c.lane * 4);
            u32x2 w; w.x = pk2(v[0], v[1]); w.y = pk2(v[2], v[3]); *(u32x2*)(c.XB + (size_t)row * D + j * 256 + c.lane * 4) = w;
            const float r0 = __uint_as_float(w.x << 16), r1 = __uint_as_float(w.x & 0xffff0000u), r2 = __uint_as_float(w.y << 16), r3 = __uint_as_float(w.y & 0xffff0000u);
            ss += (r0 * r0 + r1 * r1) + (r2 * r2 + r3 * r3); }
        ss = wave_sum(ss);
        if (c.lane < NSLOT) c.SSQ[(size_t)row * NSLOT + c.lane] = (c.lane == 0) ? ss : 0.f;
    }
}

DEV void dn_prep_rows(const Ctx& c, int l) {
    const Params& p = *c.p;
    const int gw = c.bid * 8 + c.wave, NGW = c.G * 8, lane = c.lane;
    const float* cw = p.in[I_DCW] + (size_t)l * 4 * 1536;
    for (int row = MP + gw; row < M; row += NGW) {
        const int sb = (row - MP) >> 2, pos = (row - MP) & 3; const float* hist = p.in[I_SDC] + (size_t)(l * SBATCH + sb) * 3 * 1536;
#pragma unroll
        for (int ch = 0; ch < 3; ++ch) {
            const int col = ch * 512 + lane * 8;
            float a[8];
#pragma unroll
            for (int e = 0; e < 8; ++e) a[e] = 0.f;
            float own[8];
#pragma unroll
            for (int j = 0; j < 4; ++j) {
                float v[8];
                const int sp = pos - 3 + j;
                if (sp >= 0) unpack8(*(const u32x4*)(c.PROJ + (size_t)(row - 3 + j) * NPROJ + C_QKV + col), v);
                else { const f32x4 h0 = *(const f32x4*)(hist + (size_t)(pos + j) * 1536 + col), h1 = *(const f32x4*)(hist + (size_t)(pos + j) * 1536 + col + 4);
                    v[0] = h0[0]; v[1] = h0[1]; v[2] = h0[2]; v[3] = h0[3]; v[4] = h1[0]; v[5] = h1[1]; v[6] = h1[2]; v[7] = h1[3]; }
                const f32x4 w0 = *(const f32x4*)(cw + j * 1536 + col), w1 = *(const f32x4*)(cw + j * 1536 + col + 4);
#pragma unroll
                for (int e = 0; e < 4; ++e) { a[e] += v[e] * w0[e]; a[e + 4] += v[e + 4] * w1[e]; }
                if (j == 3) {
#pragma unroll
                    for (int e = 0; e < 8; ++e) own[e] = v[e]; }
            }
            float ss = 0.f;
#pragma unroll
            for (int e = 0; e < 8; ++e) { a[e] = siluf_(a[e]); ss += a[e] * a[e]; }
            if (ch < 2) {
                ss += __shfl_xor(ss, 1); ss += __shfl_xor(ss, 2); ss += __shfl_xor(ss, 4); ss += __shfl_xor(ss, 8);
                const float sc = rsqrtf(ss + 1e-6f) * (ch == 0 ? 0.08838834764831845f : 1.f);
#pragma unroll
                for (int e = 0; e < 8; ++e) a[e] *= sc;
            }
            *(u32x4*)(c.QKVN + (size_t)(row - MP) * 1536 + col) = pack8(a);
            if (pos >= 1) { float* dst = p.out + O_SDC + ((size_t)(l * SBATCH + sb) * 3 + (pos - 1)) * 1536 + col;
                *(f32x4*)dst = (f32x4){own[0], own[1], own[2], own[3]}; *(f32x4*)(dst + 4) = (f32x4){own[4], own[5], own[6], own[7]}; }
        }
        if (lane < 4) {
            const float ain = bf2f(c.PROJ[(size_t)row * NPROJ + C_AIN + lane]), bin = bf2f(c.PROJ[(size_t)row * NPROJ + C_BIN + lane]);
            const float g = -__expf(p.in[I_ALOG][l * 4 + lane]) * softplus_(ain + p.in[I_DTB][l * 4 + lane]);
            c.GB[(size_t)(row - MP) * 8 + lane] = g; c.GB[(size_t)(row - MP) * 8 + 4 + lane] = sigm(bin);
        }
    }
}

DEV int slot_of(int idx) { return (idx & ~31) | (((idx >> 2) & 3) << 3) | (((idx >> 4) & 1) << 2) | (idx & 3); }
template <int I> struct SolveRow {
    template <int NC> static DEV void run(float (&X)[64], const LAS float* Mv, const f32x4 (&cur)[NC]) {
        constexpr int NV = (I + 3) / 4;
        constexpr int NLATE = NV > 8 ? NV - 8 : 0;
        constexpr int NN = ((I + 1 + 3) / 4) > 8 ? 8 : ((I + 1 + 3) / 4);
        f32x4 late[NLATE > 0 ? NLATE : 1];
#pragma unroll
        for (int k = 0; k < NLATE; ++k) late[k] = *(const LAS f32x4*)(Mv + I * 68 + 4 * (8 + k));
        f32x4 nxt[NN];
        if constexpr (I + 1 < 64) {
#pragma unroll
            for (int k = 0; k < NN; ++k) nxt[k] = *(const LAS f32x4*)(Mv + (I + 1) * 68 + 4 * k);
        }
        __builtin_amdgcn_sched_barrier(0);
        float a0 = X[I], a1 = 0.f, a2 = 0.f, a3 = 0.f;
#pragma unroll
        for (int k = 0; k < NV; ++k) {
            const f32x4 mv = k < 8 ? cur[k < NC ? k : 0] : late[k >= 8 ? k - 8 : 0];
            a0 -= mv[0] * X[4 * k];
            if (4 * k + 1 < I) a1 -= mv[1] * X[4 * k + 1];
            if (4 * k + 2 < I) a2 -= mv[2] * X[4 * k + 2];
            if (4 * k + 3 < I) a3 -= mv[3] * X[4 * k + 3];
        }
        X[I] = (a0 + a1) + (a2 + a3);
        __builtin_amdgcn_sched_barrier(0);
        if constexpr (I + 1 < 64) SolveRow<I + 1>::run(X, Mv, nxt);
    }
};
DEV void dn_chunk_prep(const Ctx& c, int l, int item, LAS unsigned char* lds) {
    const Params& p = *c.p;
    const int b = item >> 7, n = (item >> 2) & 31, h = item & 3, row0 = b * SEQ + n * 64, tid = c.tid, lane = c.lane, wave = c.wave;
    LAS float* Mm = (LAS float*)lds;
    LAS float* gcs = (LAS float*)(lds + 17408);
    LAS bf16_t* qn = (LAS bf16_t*)(lds + 18432);
    LAS bf16_t* kn = qn + 64 * 136;
    LAS bf16_t* vv = kn + 64 * 136;
    LAS float* bet = gcs + 64; LAS float* egs = gcs + 128; LAS float* bke = gcs + 192;
    bf16_t* QGP = c.QGP + (size_t)item * 8192; bf16_t* WP = c.WP + (size_t)item * 8192; bf16_t* KDP = c.KDP + (size_t)item * 8192;
    bf16_t* UTP = c.UTP + (size_t)item * 8192; bf16_t* ATP = c.ATP + (size_t)item * 4096;
    LAS float* cwl = (LAS float*)(lds + 70656);
    if (tid < 384) {
        const int ch = tid >> 7, cc = tid & 127;
#pragma unroll
        for (int j = 0; j < 4; ++j) cwl[j * 384 + tid] = p.in[I_DCW][(size_t)(l * 4 + j) * 1536 + ch * 512 + h * 128 + cc];
    }
    if (tid < 64) {
        const int row = row0 + tid;
        const float ain = bf2f(c.PROJ[(size_t)row * NPROJ + C_AIN + h]), bin = bf2f(c.PROJ[(size_t)row * NPROJ + C_BIN + h]);
        float g = -__expf(p.in[I_ALOG][l * 4 + h]) * softplus_(ain + p.in[I_DTB][l * 4 + h]);
        const float be = sigm(bin);
#pragma unroll
        for (int o = 1; o < 64; o <<= 1) { const float t = __shfl_up(g, o); if (lane >= o) g += t; }
        const float e = __expf(g);
        gcs[tid] = g; bet[tid] = be; egs[tid] = e; bke[tid] = be * e;
    }
    __syncthreads();
    {
        const int r = tid >> 3, sub = tid & 7, row = row0 + r;
        const float eg_r = egs[r];
#pragma unroll 1
        for (int ch = 0; ch < 3; ++ch) {
            float a[2][8]; float ss = 0.f;
#pragma unroll
            for (int gi = 0; gi < 2; ++gi) {
                const int col8 = (sub + 8 * gi) * 8, gcol = ch * 512 + h * 128 + col8;
                const LAS float* cw = cwl + ch * 128 + col8;
#pragma unroll
                for (int e = 0; e < 8; ++e) a[gi][e] = 0.f;
#pragma unroll
                for (int j = 0; j < 4; ++j) {
                    float v[8];
                    if (n > 0 || r - 3 + j >= 0) unpack8(*(const u32x4*)(c.PROJ + (size_t)(row - 3 + j) * NPROJ + C_QKV + gcol), v);
                    else {
#pragma unroll
                        for (int e = 0; e < 8; ++e) v[e] = 0.f; }
                    const f32x4 w0 = *(const LAS f32x4*)(cw + j * 384), w1 = *(const LAS f32x4*)(cw + j * 384 + 4);
#pragma unroll
                    for (int e = 0; e < 4; ++e) { a[gi][e] += v[e] * w0[e]; a[gi][e + 4] += v[e + 4] * w1[e]; }
                    if (j == 3 && n == 31 && r >= 61) { float* dst = p.out + O_PDC + ((size_t)(l * NBATCH + b) * 3 + (r - 61)) * 1536 + gcol;
                        *(f32x4*)dst = (f32x4){v[0], v[1], v[2], v[3]}; *(f32x4*)(dst + 4) = (f32x4){v[4], v[5], v[6], v[7]}; }
                }
#pragma unroll
                for (int e = 0; e < 8; ++e) { a[gi][e] = siluf_(a[gi][e]); ss += a[gi][e] * a[gi][e]; }
            }
            if (ch < 2) {
                ss += __shfl_xor(ss, 1); ss += __shfl_xor(ss, 2); ss += __shfl_xor(ss, 4);
                const float sc = rsqrtf(ss + 1e-6f) * (ch == 0 ? 0.08838834764831845f : 1.f);
#pragma unroll
                for (int gi = 0; gi < 2; ++gi)
#pragma unroll
                    for (int e = 0; e < 8; ++e) a[gi][e] *= sc;
            }
            LAS bf16_t* tile = qn + ch * (64 * 136);
#pragma unroll
            for (int gi = 0; gi < 2; ++gi) {
                const int col8 = (sub + 8 * gi) * 8;
                *(LAS u32x4*)(tile + r * 136 + col8) = pack8(a[gi]);
                if (ch == 0) {
                    const int grp = sub + 8 * gi, s = grp >> 2, aa = (grp >> 1) & 1, hh = grp & 1;
                    u32x2 w0, w1; w0.x = pk2(a[gi][0] * eg_r, a[gi][1] * eg_r); w0.y = pk2(a[gi][2] * eg_r, a[gi][3] * eg_r);
                    w1.x = pk2(a[gi][4] * eg_r, a[gi][5] * eg_r); w1.y = pk2(a[gi][6] * eg_r, a[gi][7] * eg_r);
                    *(u32x2*)(QGP + r * 128 + 32 * s + 16 * hh + 4 * aa) = w0; *(u32x2*)(QGP + r * 128 + 32 * s + 16 * hh + 8 + 4 * aa) = w1;
                }
            }
        }
    }
    __syncthreads();
    {
        const int mi = wave & 3, which = wave >> 2, fr = lane & 15, q = lane >> 4;
        const LAS bf16_t* At = which ? qn : kn;
        bf16x8 af[4];
#pragma unroll
        for (int s = 0; s < 4; ++s) af[s] = *(const LAS bf16x8*)(At + (16 * mi + fr) * 136 + 32 * s + 8 * q);
#pragma unroll
        for (int nj = 0; nj < 4; ++nj) {
            f32x4 acc = {0.f, 0.f, 0.f, 0.f};
            if (nj <= mi) {
#pragma unroll
                for (int s = 0; s < 4; ++s) { const bf16x8 bfr = *(const LAS bf16x8*)(kn + (16 * nj + fr) * 136 + 32 * s + 8 * q);
                    acc = __builtin_amdgcn_mfma_f32_16x16x32_bf16(af[s], bfr, acc, 0, 0, 0); }
            }
            const int j = 16 * nj + fr; const float gj = gcs[j];
#pragma unroll
            for (int r = 0; r < 4; ++r) {
                const int i = 16 * mi + 4 * q + r;
                if (which == 0) { if (nj <= mi) Mm[i * 68 + j] = (i > j) ? bet[i] * acc[r] * __expf(gcs[i] - gj) : 0.f; }
                else { const float v = (i >= j) ? acc[r] * __expf(gcs[i] - gj) : 0.f; ATP[i * 64 + slot_of(j)] = (bf16_t)f2bf(v); }
            }
        }
    }
    __syncthreads();
    if (wave < 4) {
        const int isK = wave >> 1, col = 64 * (wave & 1) + lane;
        const LAS bf16_t* src = isK ? kn : vv; const LAS float* mul = isK ? bke : bet;
        float X[64];
#pragma unroll
        for (int i = 0; i < 64; ++i) X[i] = bf2f(src[i * 136 + col]);
        {   int zl0 = 0; asm volatile("" : "+v"(zl0)); const LAS float* mulv = mul + zl0;
#pragma unroll
            for (int i4 = 0; i4 < 16; ++i4) { const f32x4 mm = *(const LAS f32x4*)(mulv + 4 * i4); X[4 * i4] *= mm[0]; X[4 * i4 + 1] *= mm[1]; X[4 * i4 + 2] *= mm[2]; X[4 * i4 + 3] *= mm[3]; } }
        int zl = 0; asm volatile("" : "+v"(zl));
        const LAS float* Mv = Mm + zl;
        { f32x4 cur1[1]; cur1[0] = *(const LAS f32x4*)(Mv + 68); SolveRow<1>::run(X, Mv, cur1); }
        if (!isK) {
#pragma unroll
            for (int t8 = 0; t8 < 8; ++t8) { u32x4 w; w.x = pk2(X[8 * t8], X[8 * t8 + 1]); w.y = pk2(X[8 * t8 + 2], X[8 * t8 + 3]); w.z = pk2(X[8 * t8 + 4], X[8 * t8 + 5]); w.w = pk2(X[8 * t8 + 6], X[8 * t8 + 7]);
                *(u32x4*)(UTP + col * 64 + 8 * t8) = w; }
        } else {
            const int sl = slot_of(col);
#pragma unroll
            for (int t = 0; t < 64; ++t) WP[t * 128 + sl] = (bf16_t)f2bf(X[t]);
        }
    } else {
        const int tt = tid - 256, dk = tt >> 1, s = tt & 1;
        const float gl = gcs[63];
#pragma unroll
        for (int qq = 0; qq < 4; ++qq) {
            float v[8];
#pragma unroll
            for (int j = 0; j < 8; ++j) { const int t = 32 * s + 16 * (j >> 2) + 4 * qq + (j & 3); v[j] = bf2f(kn[t * 136 + dk]) * __expf(gl - gcs[t]); }
            *(u32x4*)(KDP + dk * 64 + 32 * s + 8 * qq) = pack8(v);
        }
        if (tt == 0) c.GL[item] = __expf(gl);
    }
    __syncthreads();
}

DEV void dn_chunk_scan(const Ctx& c, int l, int b, int h, LAS unsigned char* lds) {
    const Params& p = *c.p;
    const int tid = c.tid, lane = c.lane, wave = c.wave, fr = lane & 15, q = lane >> 4, dvc = 16 * wave + fr;
    LAS unsigned char* wl = lds;
    LAS unsigned char* ql = lds + 17408;
    LAS unsigned char* kl = lds + 34816;
    LAS unsigned char* al = lds + 53248;
    LAS float* obuf = (LAS float*)(lds + 62464);
    unsigned soff[7], doff[7];
#pragma unroll
    for (int k = 0; k < 7; ++k) {
        const int pc = tid + 512 * k;
        if (k < 2) { soff[k] = pc * 16; doff[k] = (pc >> 4) * 272 + (pc & 15) * 16; }
        else if (k < 4) { const int pp = pc - 1024; soff[k] = pp * 16; doff[k] = 17408 + (pp >> 4) * 272 + (pp & 15) * 16; }
        else if (k < 6) { const int pp = pc - 2048; soff[k] = pp * 16; doff[k] = 34816 + (pp >> 3) * 144 + (pp & 7) * 16; }
        else { const int pp = pc - 3072; soff[k] = pp * 16; doff[k] = 53248 + (pp >> 3) * 144 + (pp & 7) * 16; }
    }
    const int it0 = (b * 32) * 4 + h;
    u32x4 pf[7];
#define DN_LOAD(itm) do { const size_t io = (size_t)(itm) * 16384; \
        pf[0] = *(const u32x4*)((const char*)c.WP + io + soff[0]); pf[1] = *(const u32x4*)((const char*)c.WP + io + soff[1]); \
        pf[2] = *(const u32x4*)((const char*)c.QGP + io + soff[2]); pf[3] = *(const u32x4*)((const char*)c.QGP + io + soff[3]); \
        pf[4] = *(const u32x4*)((const char*)c.KDP + io + soff[4]); pf[5] = *(const u32x4*)((const char*)c.KDP + io + soff[5]); \
        pf[6] = *(const u32x4*)((const char*)c.ATP + (size_t)(itm) * 8192 + soff[6]); } while (0)
#define DN_STORE() do { _Pragma("unroll") for (int k = 0; k < 7; ++k) *(LAS u32x4*)(lds + doff[k]) = pf[k]; } while (0)
    DN_LOAD(it0); DN_STORE();
    __syncthreads();
    f32x4 S[8];
#pragma unroll
    for (int i = 0; i < 8; ++i) S[i] = (f32x4){0.f, 0.f, 0.f, 0.f};
    const int ft = tid >> 3, fc = (tid & 7) * 16;
    f32x4 nw[4];
#pragma unroll
    for (int k = 0; k < 4; ++k) nw[k] = *(const f32x4*)(p.in[I_DNW] + l * 128 + fc + 4 * k);
    u32x2 uu[4], un[4]; float gl = c.GL[it0], gln = 0.f;
#pragma unroll
    for (int m = 0; m < 4; ++m) { uu[m] = *(const u32x2*)(c.UTP + (size_t)it0 * 8192 + dvc * 64 + 16 * m + 4 * q); un[m] = uu[m]; }
    for (int n = 0; n < 32; ++n) {
        const int itm = it0 + n * 4;
        if (n + 1 < 32) {
#pragma unroll
            for (int m = 0; m < 4; ++m) un[m] = *(const u32x2*)(c.UTP + (size_t)(itm + 4) * 8192 + dvc * 64 + 16 * m + 4 * q);
            gln = c.GL[itm + 4];
        }
        const u32x4 zr0 = *(const u32x4*)(c.PROJ + (size_t)(b * SEQ + n * 64 + ft) * NPROJ + C_Z + h * 128 + fc), zr1 = *(const u32x4*)(c.PROJ + (size_t)(b * SEQ + n * 64 + ft) * NPROJ + C_Z + h * 128 + fc + 8);
        if (n + 1 < 32) DN_LOAD(itm + 4);
        bf16x8 Sb[4];
#pragma unroll
        for (int s = 0; s < 4; ++s) { union { u32x4 u; bf16x8 v; } t; t.u.x = pk2(S[2 * s][0], S[2 * s][1]); t.u.y = pk2(S[2 * s][2], S[2 * s][3]); t.u.z = pk2(S[2 * s + 1][0], S[2 * s + 1][1]); t.u.w = pk2(S[2 * s + 1][2], S[2 * s + 1][3]); Sb[s] = t.v; }
        f32x4 vn[4]; bf16x8 vb[2]; bf16x8 fa[6], fb[6];
        fa[0] = *(const LAS bf16x8*)(wl + (16 * 0 + fr) * 272 + 64 * 0 + 16 * q); fa[1] = *(const LAS bf16x8*)(wl + (16 * 0 + fr) * 272 + 64 * 1 + 16 * q); fa[2] = *(const LAS bf16x8*)(wl + (16 * 0 + fr) * 272 + 64 * 2 + 16 * q); fa[3] = *(const LAS bf16x8*)(wl + (16 * 0 + fr) * 272 + 64 * 3 + 16 * q);
        fb[0] = *(const LAS bf16x8*)(wl + (16 * 1 + fr) * 272 + 64 * 0 + 16 * q); fb[1] = *(const LAS bf16x8*)(wl + (16 * 1 + fr) * 272 + 64 * 1 + 16 * q); fb[2] = *(const LAS bf16x8*)(wl + (16 * 1 + fr) * 272 + 64 * 2 + 16 * q); fb[3] = *(const LAS bf16x8*)(wl + (16 * 1 + fr) * 272 + 64 * 3 + 16 * q);
        __builtin_amdgcn_sched_barrier(0);
            { f32x4 P = {0.f, 0.f, 0.f, 0.f};
              P = __builtin_amdgcn_mfma_f32_16x16x32_bf16(fa[0], Sb[0], P, 0, 0, 0);
              P = __builtin_amdgcn_mfma_f32_16x16x32_bf16(fa[1], Sb[1], P, 0, 0, 0);
              P = __builtin_amdgcn_mfma_f32_16x16x32_bf16(fa[2], Sb[2], P, 0, 0, 0);
              P = __builtin_amdgcn_mfma_f32_16x16x32_bf16(fa[3], Sb[3], P, 0, 0, 0);
              vn[0][0] = __uint_as_float(uu[0].x << 16) - P[0]; vn[0][1] = __uint_as_float(uu[0].x & 0xffff0000u) - P[1]; vn[0][2] = __uint_as_float(uu[0].y << 16) - P[2]; vn[0][3] = __uint_as_float(uu[0].y & 0xffff0000u) - P[3]; }
        __builtin_amdgcn_sched_barrier(0);
        fa[0] = *(const LAS bf16x8*)(wl + (16 * 2 + fr) * 272 + 64 * 0 + 16 * q); fa[1] = *(const LAS bf16x8*)(wl + (16 * 2 + fr) * 272 + 64 * 1 + 16 * q); fa[2] = *(const LAS bf16x8*)(wl + (16 * 2 + fr) * 272 + 64 * 2 + 16 * q); fa[3] = *(const LAS bf16x8*)(wl + (16 * 2 + fr) * 272 + 64 * 3 + 16 * q);
        __builtin_amdgcn_sched_barrier(0);
            { f32x4 P = {0.f, 0.f, 0.f, 0.f};
              P = __builtin_amdgcn_mfma_f32_16x16x32_bf16(fb[0], Sb[0], P, 0, 0, 0);
              P = __builtin_amdgcn_mfma_f32_16x16x32_bf16(fb[1], Sb[1], P, 0, 0, 0);
              P = __builtin_amdgcn_mfma_f32_16x16x32_bf16(fb[2], Sb[2], P, 0, 0, 0);
              P = __builtin_amdgcn_mfma_f32_16x16x32_bf16(fb[3], Sb[3], P, 0, 0, 0);
              vn[1][0] = __uint_as_float(uu[1].x << 16) - P[0]; vn[1][1] = __uint_as_float(uu[1].x & 0xffff0000u) - P[1]; vn[1][2] = __uint_as_float(uu[1].y << 16) - P[2]; vn[1][3] = __uint_as_float(uu[1].y & 0xffff0000u) - P[3]; }
        __builtin_amdgcn_sched_barrier(0);
        fb[0] = *(const LAS bf16x8*)(wl + (16 * 3 + fr) * 272 + 64 * 0 + 16 * q); fb[1] = *(const LAS bf16x8*)(wl + (16 * 3 + fr) * 272 + 64 * 1 + 16 * q); fb[2] = *(const LAS bf16x8*)(wl + (16 * 3 + fr) * 272 + 64 * 2 + 16 * q); fb[3] = *(const LAS bf16x8*)(wl + (16 * 3 + fr) * 272 + 64 * 3 + 16 * q);
        __builtin_amdgcn_sched_barrier(0);
            { f32x4 P = {0.f, 0.f, 0.f, 0.f};
              P = __builtin_amdgcn_mfma_f32_16x16x32_bf16(fa[0], Sb[0], P, 0, 0, 0);
              P = __builtin_amdgcn_mfma_f32_16x16x32_bf16(fa[1], Sb[1], P, 0, 0, 0);
              P = __builtin_amdgcn_mfma_f32_16x16x32_bf16(fa[2], Sb[2], P, 0, 0, 0);
              P = __builtin_amdgcn_mfma_f32_16x16x32_bf16(fa[3], Sb[3], P, 0, 0, 0);
              vn[2][0] = __uint_as_float(uu[2].x << 16) - P[0]; vn[2][1] = __uint_as_float(uu[2].x & 0xffff0000u) - P[1]; vn[2][2] = __uint_as_float(uu[2].y << 16) - P[2]; vn[2][3] = __uint_as_float(uu[2].y & 0xffff0000u) - P[3]; }
        __builtin_amdgcn_sched_barrier(0);
        fa[0] = *(const LAS bf16x8*)(ql + (16 * 0 + fr) * 272 + 64 * 0 + 16 * q); fa[1] = *(const LAS bf16x8*)(ql + (16 * 0 + fr) * 272 + 64 * 1 + 16 * q); fa[2] = *(const LAS bf16x8*)(ql + (16 * 0 + fr) * 272 + 64 * 2 + 16 * q); fa[3] = *(const LAS bf16x8*)(ql + (16 * 0 + fr) * 272 + 64 * 3 + 16 * q); fa[4] = *(const LAS bf16x8*)(al + (16 * 0 + fr) * 144 + 64 * 0 + 16 * q); fa[5] = *(const LAS bf16x8*)(al + (16 * 0 + fr) * 144 + 64 * 1 + 16 * q);
        __builtin_amdgcn_sched_barrier(0);
            { f32x4 P = {0.f, 0.f, 0.f, 0.f};
              P = __builtin_amdgcn_mfma_f32_16x16x32_bf16(fb[0], Sb[0], P, 0, 0, 0);
              P = __builtin_amdgcn_mfma_f32_16x16x32_bf16(fb[1], Sb[1], P, 0, 0, 0);
              P = __builtin_amdgcn_mfma_f32_16x16x32_bf16(fb[2], Sb[2], P, 0, 0, 0);
              P = __builtin_amdgcn_mfma_f32_16x16x32_bf16(fb[3], Sb[3], P, 0, 0, 0);
              vn[3][0] = __uint_as_float(uu[3].x << 16) - P[0]; vn[3][1] = __uint_as_float(uu[3].x & 0xffff0000u) - P[1]; vn[3][2] = __uint_as_float(uu[3].y << 16) - P[2]; vn[3][3] = __uint_as_float(uu[3].y & 0xffff0000u) - P[3]; }
            for (int s = 0; s < 2; ++s) { union { u32x4 u; bf16x8 v; } t; t.u.x = pk2(vn[2 * s][0], vn[2 * s][1]); t.u.y = pk2(vn[2 * s][2], vn[2 * s][3]); t.u.z = pk2(vn[2 * s + 1][0], vn[2 * s + 1][1]); t.u.w = pk2(vn[2 * s + 1][2], vn[2 * s + 1][3]); vb[s] = t.v; }
        __builtin_amdgcn_sched_barrier(0);
        fb[0] = *(const LAS bf16x8*)(ql + (16 * 1 + fr) * 272 + 64 * 0 + 16 * q); fb[1] = *(const LAS bf16x8*)(ql + (16 * 1 + fr) * 272 + 64 * 1 + 16 * q); fb[2] = *(const LAS bf16x8*)(ql + (16 * 1 + fr) * 272 + 64 * 2 + 16 * q); fb[3] = *(const LAS bf16x8*)(ql + (16 * 1 + fr) * 272 + 64 * 3 + 16 * q); fb[4] = *(const LAS bf16x8*)(al + (16 * 1 + fr) * 144 + 64 * 0 + 16 * q); fb[5] = *(const LAS bf16x8*)(al + (16 * 1 + fr) * 144 + 64 * 1 + 16 * q);
        __builtin_amdgcn_sched_barrier(0);
            { f32x4 O = {0.f, 0.f, 0.f, 0.f};
              O = __builtin_amdgcn_mfma_f32_16x16x32_bf16(fa[0], Sb[0], O, 0, 0, 0);
              O = __builtin_amdgcn_mfma_f32_16x16x32_bf16(fa[1], Sb[1], O, 0, 0, 0);
              O = __builtin_amdgcn_mfma_f32_16x16x32_bf16(fa[2], Sb[2], O, 0, 0, 0);
              O = __builtin_amdgcn_mfma_f32_16x16x32_bf16(fa[3], Sb[3], O, 0, 0, 0);
              O = __builtin_amdgcn_mfma_f32_16x16x32_bf16(fa[4], vb[0], O, 0, 0, 0);
              O = __builtin_amdgcn_mfma_f32_16x16x32_bf16(fa[5], vb[1], O, 0, 0, 0);
              for (int r = 0; r < 4; ++r) obuf[(16 * 0 + 4 * q + r) * 132 + dvc] = O[r]; }
        __builtin_amdgcn_sched_barrier(0);
        fa[0] = *(const LAS bf16x8*)(ql + (16 * 2 + fr) * 272 + 64 * 0 + 16 * q); fa[1] = *(const LAS bf16x8*)(ql + (16 * 2 + fr) * 272 + 64 * 1 + 16 * q); fa[2] = *(const LAS bf16x8*)(ql + (16 * 2 + fr) * 272 + 64 * 2 + 16 * q); fa[3] = *(const LAS bf16x8*)(ql + (16 * 2 + fr) * 272 + 64 * 3 + 16 * q); fa[4] = *(const LAS bf16x8*)(al + (16 * 2 + fr) * 144 + 64 * 0 + 16 * q); fa[5] = *(const LAS bf16x8*)(al + (16 * 2 + fr) * 144 + 64 * 1 + 16 * q);
        __builtin_amdgcn_sched_barrier(0);
            { f32x4 O = {0.f, 0.f, 0.f, 0.f};
              O = __builtin_amdgcn_mfma_f32_16x16x32_bf16(fb[0], Sb[0], O, 0, 0, 0);
              O = __builtin_amdgcn_mfma_f32_16x16x32_bf16(fb[1], Sb[1], O, 0, 0, 0);
              O = __builtin_amdgcn_mfma_f32_16x16x32_bf16(fb[2], Sb[2], O, 0, 0, 0);
              O = __builtin_amdgcn_mfma_f32_16x16x32_bf16(fb[3], Sb[3], O, 0, 0, 0);
              O = __builtin_amdgcn_mfma_f32_16x16x32_bf16(fb[4], vb[0], O, 0, 0, 0);
              O = __builtin_amdgcn_mfma_f32_16x16x32_bf16(fb[5], vb[1], O, 0, 0, 0);
              for (int r = 0; r < 4; ++r) obuf[(16 * 1 + 4 * q + r) * 132 + dvc] = O[r]; }
        __builtin_amdgcn_sched_barrier(0);
        fb[0] = *(const LAS bf16x8*)(ql + (16 * 3 + fr) * 272 + 64 * 0 + 16 * q); fb[1] = *(const LAS bf16x8*)(ql + (16 * 3 + fr) * 272 + 64 * 1 + 16 * q); fb[2] = *(const LAS bf16x8*)(ql + (16 * 3 + fr) * 272 + 64 * 2 + 16 * q); fb[3] = *(const LAS bf16x8*)(ql + (16 * 3 + fr) * 272 + 64 * 3 + 16 * q); fb[4] = *(const LAS bf16x8*)(al + (16 * 3 + fr) * 144 + 64 * 0 + 16 * q); fb[5] = *(const LAS bf16x8*)(al + (16 * 3 + fr) * 144 + 64 * 1 + 16 * q);
        __builtin_amdgcn_sched_barrier(0);
            { f32x4 O = {0.f, 0.f, 0.f, 0.f};
              O = __builtin_amdgcn_mfma_f32_16x16x32_bf16(fa[0], Sb[0], O, 0, 0, 0);
              O = __builtin_amdgcn_mfma_f32_16x16x32_bf16(fa[1], Sb[1], O, 0, 0, 0);
              O = __builtin_amdgcn_mfma_f32_16x16x32_bf16(fa[2], Sb[2], O, 0, 0, 0);
              O = __builtin_amdgcn_mfma_f32_16x16x32_bf16(fa[3], Sb[3], O, 0, 0, 0);
              O = __builtin_amdgcn_mfma_f32_16x16x32_bf16(fa[4], vb[0], O, 0, 0, 0);
              O = __builtin_amdgcn_mfma_f32_16x16x32_bf16(fa[5], vb[1], O, 0, 0, 0);
              for (int r = 0; r < 4; ++r) obuf[(16 * 2 + 4 * q + r) * 132 + dvc] = O[r]; }
        __builtin_amdgcn_sched_barrier(0);
        fa[0] = *(const LAS bf16x8*)(kl + (16 * 0 + fr) * 144 + 64 * 0 + 16 * q); fa[1] = *(const LAS bf16x8*)(kl + (16 * 0 + fr) * 144 + 64 * 1 + 16 * q); fa[2] = *(const LAS bf16x8*)(kl + (16 * 1 + fr) * 144 + 64 * 0 + 16 * q); fa[3] = *(const LAS bf16x8*)(kl + (16 * 1 + fr) * 144 + 64 * 1 + 16 * q);
        __builtin_amdgcn_sched_barrier(0);
            { f32x4 O = {0.f, 0.f, 0.f, 0.f};
              O = __builtin_amdgcn_mfma_f32_16x16x32_bf16(fb[0], Sb[0], O, 0, 0, 0);
              O = __builtin_amdgcn_mfma_f32_16x16x32_bf16(fb[1], Sb[1], O, 0, 0, 0);
              O = __builtin_amdgcn_mfma_f32_16x16x32_bf16(fb[2], Sb[2], O, 0, 0, 0);
              O = __builtin_amdgcn_mfma_f32_16x16x32_bf16(fb[3], Sb[3], O, 0, 0, 0);
              O = __builtin_amdgcn_mfma_f32_16x16x32_bf16(fb[4], vb[0], O, 0, 0, 0);
              O = __builtin_amdgcn_mfma_f32_16x16x32_bf16(fb[5], vb[1], O, 0, 0, 0);
              for (int r = 0; r < 4; ++r) obuf[(16 * 3 + 4 * q + r) * 132 + dvc] = O[r]; }
        __builtin_amdgcn_sched_barrier(0);
        fb[0] = *(const LAS bf16x8*)(kl + (16 * 2 + fr) * 144 + 64 * 0 + 16 * q); fb[1] = *(const LAS bf16x8*)(kl + (16 * 2 + fr) * 144 + 64 * 1 + 16 * q); fb[2] = *(const LAS bf16x8*)(kl + (16 * 3 + fr) * 144 + 64 * 0 + 16 * q); fb[3] = *(const LAS bf16x8*)(kl + (16 * 3 + fr) * 144 + 64 * 1 + 16 * q);
        __builtin_amdgcn_sched_barrier(0);
            { f32x4 a0 = S[0] * gl; a0 = __builtin_amdgcn_mfma_f32_16x16x32_bf16(fa[0], vb[0], a0, 0, 0, 0); a0 = __builtin_amdgcn_mfma_f32_16x16x32_bf16(fa[1], vb[1], a0, 0, 0, 0); S[0] = a0; f32x4 a1 = S[1] * gl; a1 = __builtin_amdgcn_mfma_f32_16x16x32_bf16(fa[2], vb[0], a1, 0, 0, 0); a1 = __builtin_amdgcn_mfma_f32_16x16x32_bf16(fa[3], vb[1], a1, 0, 0, 0); S[1] = a1; }
        __builtin_amdgcn_sched_barrier(0);
        fa[0] = *(const LAS bf16x8*)(kl + (16 * 4 + fr) * 144 + 64 * 0 + 16 * q); fa[1] = *(const LAS bf16x8*)(kl + (16 * 4 + fr) * 144 + 64 * 1 + 16 * q); fa[2] = *(const LAS bf16x8*)(kl + (16 * 5 + fr) * 144 + 64 * 0 + 16 * q); fa[3] = *(const LAS bf16x8*)(kl + (16 * 5 + fr) * 144 + 64 * 1 + 16 * q);
        __builtin_amdgcn_sched_barrier(0);
            { f32x4 a0 = S[2] * gl; a0 = __builtin_amdgcn_mfma_f32_16x16x32_bf16(fb[0], vb[0], a0, 0, 0, 0); a0 = __builtin_amdgcn_mfma_f32_16x16x32_bf16(fb[1], vb[1], a0, 0, 0, 0); S[2] = a0; f32x4 a1 = S[3] * gl; a1 = __builtin_amdgcn_mfma_f32_16x16x32_bf16(fb[2], vb[0], a1, 0, 0, 0); a1 = __builtin_amdgcn_mfma_f32_16x16x32_bf16(fb[3], vb[1], a1, 0, 0, 0); S[3] = a1; }
        __builtin_amdgcn_sched_barrier(0);
        fb[0] = *(const LAS bf16x8*)(kl + (16 * 6 + fr) * 144 + 64 * 0 + 16 * q); fb[1] = *(const LAS bf16x8*)(kl + (16 * 6 + fr) * 144 + 64 * 1 + 16 * q); fb[2] = *(const LAS bf16x8*)(kl + (16 * 7 + fr) * 144 + 64 * 0 + 16 * q); fb[3] = *(const LAS bf16x8*)(kl + (16 * 7 + fr) * 144 + 64 * 1 + 16 * q);
        __builtin_amdgcn_sched_barrier(0);
            { f32x4 a0 = S[4] * gl; a0 = __builtin_amdgcn_mfma_f32_16x16x32_bf16(fa[0], vb[0], a0, 0, 0, 0); a0 = __builtin_amdgcn_mfma_f32_16x16x32_bf16(fa[1], vb[1], a0, 0, 0, 0); S[4] = a0; f32x4 a1 = S[5] * gl; a1 = __builtin_amdgcn_mfma_f32_16x16x32_bf16(fa[2], vb[0], a1, 0, 0, 0); a1 = __builtin_amdgcn_mfma_f32_16x16x32_bf16(fa[3], vb[1], a1, 0, 0, 0); S[5] = a1; }
        __builtin_amdgcn_sched_barrier(0);
        __builtin_amdgcn_sched_barrier(0);
            { f32x4 a0 = S[6] * gl; a0 = __builtin_amdgcn_mfma_f32_16x16x32_bf16(fb[0], vb[0], a0, 0, 0, 0); a0 = __builtin_amdgcn_mfma_f32_16x16x32_bf16(fb[1], vb[1], a0, 0, 0, 0); S[6] = a0; f32x4 a1 = S[7] * gl; a1 = __builtin_amdgcn_mfma_f32_16x16x32_bf16(fb[2], vb[0], a1, 0, 0, 0); a1 = __builtin_amdgcn_mfma_f32_16x16x32_bf16(fb[3], vb[1], a1, 0, 0, 0); S[7] = a1; }
        __builtin_amdgcn_sched_barrier(0);
        __syncthreads();
        if (n + 1 < 32) DN_STORE();
#pragma unroll
        for (int m = 0; m < 4; ++m) uu[m] = un[m];
        gl = gln;
        {
            const int row = b * SEQ + n * 64 + ft;
            f32x4 o4[4]; float ss = 0.f;
#pragma unroll
            for (int k = 0; k < 4; ++k) { o4[k] = *(const LAS f32x4*)(obuf + ft * 132 + fc + 4 * k); ss += (o4[k][0] * o4[k][0] + o4[k][1] * o4[k][1]) + (o4[k][2] * o4[k][2] + o4[k][3] * o4[k][3]); }
            ss += __shfl_xor(ss, 1); ss += __shfl_xor(ss, 2); ss += __shfl_xor(ss, 4);
            const float rs = rsqrtf(ss * (1.f / 128.f) + 1e-6f);
            float z[16]; { float z0[8], z1[8]; unpack8(zr0, z0); unpack8(zr1, z1);
#pragma unroll
                for (int e = 0; e < 8; ++e) { z[e] = z0[e]; z[8 + e] = z1[e]; } }
            float o[16];
#pragma unroll
            for (int e = 0; e < 16; ++e) o[e] = o4[e >> 2][e & 3] * rs * nw[e >> 2][e & 3] * siluf_(z[e]);
            u32x4 w0, w1; w0.x = pk2(o[0], o[1]); w0.y = pk2(o[2], o[3]); w0.z = pk2(o[4], o[5]); w0.w = pk2(o[6], o[7]); w1.x = pk2(o[8], o[9]); w1.y = pk2(o[10], o[11]); w1.z = pk2(o[12], o[13]); w1.w = pk2(o[14], o[15]);
            *(u32x4*)(c.OAB + (size_t)row * D + h * 128 + fc) = w0; *(u32x4*)(c.OAB + (size_t)row * D + h * 128 + fc + 8) = w1;
        }
        __syncthreads();
    }
#undef DN_LOAD
#undef DN_STORE
    float* So = p.out + O_PDN + (size_t)((l * NBATCH + b) * 4 + h) * 16384;
#pragma unroll
    for (int i = 0; i < 8; ++i)
#pragma unroll
        for (int r = 0; r < 4; ++r) So[(size_t)(16 * i + 4 * q + r) * 128 + dvc] = S[i][r];
    __syncthreads();
}

DEV void lru_items(const Ctx& c, int l, int first, int stride, int total, int mode, LAS unsigned char* lds) {
    if (first >= total) return;
    const Params& p = *c.p;
    const int blk = first & 3, tid = c.tid, lane = c.lane;
    LAS float* xc = (LAS float*)lds;
    const int w = c.wave, fr = lane & 15, q = lane >> 4, d = 16 * w + fr, ch = blk * 128 + d;
    bf16x8 ba_[4], bx_[4];
    {
        const bf16_t* waT = (const bf16_t*)(wbuf(c, l) + WO_LWA) + (size_t)(blk * 128 + d) * 128 + 8 * q;
        const bf16_t* wxT = (const bf16_t*)(wbuf(c, l) + WO_LWX) + (size_t)(blk * 128 + d) * 128 + 8 * q;
#pragma unroll
        for (int s = 0; s < 4; ++s) { ba_[s] = *(const bf16x8*)(waT + 32 * s); bx_[s] = *(const bf16x8*)(wxT + 32 * s); }
    }
    const float bias_a = p.in[I_LBA][l * 512 + ch], bias_x = p.in[I_LBX][l * 512 + ch];
    const float spl = softplus_(-p.in[I_LAM][l * 512 + ch]);
    const int cr = tid >> 3, c0 = (tid & 7) * 16;
    u32x4 pre[2][4];
#define LRU_PREF(item) do { const int _row = ((item) >> 2) * 64 + cr; _Pragma("unroll") for (int hf = 0; hf < 2; ++hf) _Pragma("unroll") for (int j = 0; j < 4; ++j) { \
        const int _rr = _row - 3 + j; pre[hf][j] = *(const u32x4*)(c.PROJ + (size_t)(_rr < 0 ? 0 : _rr) * NPROJ + C_LX + blk * 128 + c0 + hf * 8); } } while (0)
    LRU_PREF(first);
    for (int item = first; item < total; item += stride) {
        const int rt = item >> 2, row0 = rt * 64;
        {
            const int row = row0 + cr;
            int pos, sb = 0; const float* hist = nullptr;
            if (row < MP) pos = row & (SEQ - 1); else { sb = (row - MP) >> 2; pos = (row - MP) & 3; hist = p.in[I_SLC] + (size_t)(l * SBATCH + sb) * 3 * 512; }
#pragma unroll
            for (int hf = 0; hf < 2; ++hf) {
                const int cc = blk * 128 + c0 + hf * 8;
                float a[8], own[8];
                { const f32x4 b0 = *(const f32x4*)(p.in[I_LCB] + l * 512 + cc), b1 = *(const f32x4*)(p.in[I_LCB] + l * 512 + cc + 4);
                  a[0] = b0[0]; a[1] = b0[1]; a[2] = b0[2]; a[3] = b0[3]; a[4] = b1[0]; a[5] = b1[1]; a[6] = b1[2]; a[7] = b1[3]; }
#pragma unroll
                for (int j = 0; j < 4; ++j) {
                    float v[8];
                    const int sp = pos - 3 + j;
                    unpack8(pre[hf][j], v);
                    if (sp < 0) {
                        if (hist) { const f32x4 h0 = *(const f32x4*)(hist + (size_t)(pos + j) * 512 + cc), h1 = *(const f32x4*)(hist + (size_t)(pos + j) * 512 + cc + 4);
                            v[0] = h0[0]; v[1] = h0[1]; v[2] = h0[2]; v[3] = h0[3]; v[4] = h1[0]; v[5] = h1[1]; v[6] = h1[2]; v[7] = h1[3]; }
                        else {
#pragma unroll
                            for (int e = 0; e < 8; ++e) v[e] = 0.f; }
                    }
                    const float* cw = p.in[I_LCW] + (size_t)(l * 4 + j) * 512 + cc;
                    const f32x4 w0 = *(const f32x4*)cw, w1 = *(const f32x4*)(cw + 4);
#pragma unroll
                    for (int e = 0; e < 4; ++e) { a[e] += v[e] * w0[e]; a[e + 4] += v[e + 4] * w1[e]; }
                    if (j == 3) {
#pragma unroll
                        for (int e = 0; e < 8; ++e) own[e] = v[e]; }
                }
                *(LAS f32x4*)(xc + cr * 132 + c0 + hf * 8) = (f32x4){a[0], a[1], a[2], a[3]}; *(LAS f32x4*)(xc + cr * 132 + c0 + hf * 8 + 4) = (f32x4){a[4], a[5], a[6], a[7]};
                if (mode == 1) {
                    float* dst = nullptr;
                    if (row < MP) { if (pos >= SEQ - 3) dst = p.out + O_PLC + ((size_t)(l * NBATCH + (row >> 11)) * 3 + (pos - (SEQ - 3))) * 512 + cc; }
                    else if (pos >= 1) dst = p.out + O_SLC + ((size_t)(l * SBATCH + sb) * 3 + (pos - 1)) * 512 + cc;
                    if (dst) { *(f32x4*)dst = (f32x4){own[0], own[1], own[2], own[3]}; *(f32x4*)(dst + 4) = (f32x4){own[4], own[5], own[6], own[7]}; }
                }
            }
        }
        if (item + stride < total) LRU_PREF(item + stride);
        unsigned short yraw[4][4];
        float ca[8], chh[8];
        const int bq = rt >> 5, ci = rt & 31;
        if (mode == 1) {
#pragma unroll
            for (int m = 0; m < 4; ++m)
#pragma unroll
                for (int r = 0; r < 4; ++r) yraw[m][r] = c.PROJ[(size_t)(row0 + 16 * m + 4 * q + r) * NPROJ + C_LY + ch];
            if (row0 < MP) {
#pragma unroll
                for (int jj = 0; jj < 8; ++jj) { const size_t o = (size_t)((bq * 32 + 8 * q + jj) * 512 + ch); ca[jj] = c.CSA[o]; chh[jj] = c.CSH[o]; }
            }
        }
        __syncthreads();
        float av[4][4], bv[4][4];
#pragma unroll
        for (int m = 0; m < 4; ++m) {
            f32x4 aa = {0.f, 0.f, 0.f, 0.f}, ax = {0.f, 0.f, 0.f, 0.f};
#pragma unroll
            for (int s = 0; s < 4; ++s) {
                const LAS float* src = xc + (16 * m + fr) * 132 + 32 * s + 8 * q;
                const f32x4 x0 = *(const LAS f32x4*)src, x1 = *(const LAS f32x4*)(src + 4);
                union { u32x4 u; bf16x8 b; } af; af.u.x = pk2(x0[0], x0[1]); af.u.y = pk2(x0[2], x0[3]); af.u.z = pk2(x1[0], x1[1]); af.u.w = pk2(x1[2], x1[3]);
                aa = __builtin_amdgcn_mfma_f32_16x16x32_bf16(af.b, ba_[s], aa, 0, 0, 0);
                ax = __builtin_amdgcn_mfma_f32_16x16x32_bf16(af.b, bx_[s], ax, 0, 0, 0);
            }
#pragma unroll
            for (int r = 0; r < 4; ++r) {
                const int rowl = 16 * m + 4 * q + r, row = row0 + rowl;
                const float rr = sigm(aa[r] + bias_a), ii = sigm(ax[r] + bias_x);
                const float la = -8.f * rr * spl;
                float mult = sqrtf(neg_expm1(2.f * la));
                if (row < MP && (row & (SEQ - 1)) == 0) mult = 1.f;
                av[m][r] = __expf(la); bv[m][r] = mult * ii * xc[rowl * 132 + d];
            }
        }
        if (row0 < MP) {
            float carry = 0.f;
            if (mode == 1) {
                float Aq = 1.f, Hq = 0.f;
#pragma unroll
                for (int jj = 0; jj < 8; ++jj) { const bool on = (8 * q + jj) < ci; Hq = on ? ca[jj] * Hq + chh[jj] : Hq; Aq = on ? Aq * ca[jj] : Aq; }
#pragma unroll
                for (int qq = 0; qq < 4; ++qq) { const float A_ = __shfl(Aq, fr + 16 * qq), H_ = __shfl(Hq, fr + 16 * qq); carry = A_ * carry + H_; }
            }
            float tA = 1.f, tH = 0.f;
#pragma unroll
            for (int m = 0; m < 4; ++m) {
                float As = av[m][0], Bs = bv[m][0];
#pragma unroll
                for (int r = 1; r < 4; ++r) { Bs = av[m][r] * Bs + bv[m][r]; As *= av[m][r]; }
                float hs = carry, hn = carry;
#pragma unroll
                for (int qq = 0; qq < 4; ++qq) { const float Aq = __shfl(As, fr + 16 * qq), Bq = __shfl(Bs, fr + 16 * qq);
                    if (qq < q) hs = Aq * hs + Bq;
                    hn = Aq * hn + Bq;
                    tH = Aq * tH + Bq; tA *= Aq; }
                if (mode == 1) {
                    float hcur = hs;
#pragma unroll
                    for (int r = 0; r < 4; ++r) { const int row = row0 + 16 * m + 4 * q + r;
                        hcur = av[m][r] * hcur + bv[m][r];
                        c.OAB[(size_t)row * D + 512 + ch] = (bf16_t)f2bf(hcur * gelu_t(bf2f(yraw[m][r]))); }
                    if (ci == 31 && m == 3 && q == 3) p.out[O_PL + (size_t)(l * NBATCH + bq) * 512 + ch] = hcur;
                }
                carry = hn;
            }
            if (mode == 0 && q == 0) { const size_t o = (size_t)(rt * 512 + ch); c.CSA[o] = tA; c.CSH[o] = tH; }
        } else if (mode == 1) {
#pragma unroll
            for (int m = 0; m < 4; ++m) { const int sb = (rt - MP / 64) * 16 + 4 * m + q;
                float hcur = p.in[I_SL][(size_t)(l * SBATCH + sb) * 512 + ch];
#pragma unroll
                for (int r = 0; r < 4; ++r) { const int row = row0 + 16 * m + 4 * q + r;
                    hcur = av[m][r] * hcur + bv[m][r];
                    c.OAB[(size_t)row * D + 512 + ch] = (bf16_t)f2bf(hcur * gelu_t(bf2f(yraw[m][r]))); }
                p.out[O_SL + (size_t)(l * SBATCH + sb) * 512 + ch] = hcur; }
        }
        __syncthreads();
    }
#undef LRU_PREF
}

DEV void dn_scan_item(const Ctx& c, int l, int row0, int ntok, int h, const float* S0, float* Sout, LAS unsigned char* lds) {
    const Params& p = *c.p;
    const int tid = c.tid, kg = tid >> 7, v = tid & 127, lane = c.lane, wave = c.wave;
    LAS float* qk = (LAS float*)lds;
    LAS float* rpart = qk + 512;
    LAS float* opart = rpart + 512;
    LAS float* ssb = opart + 512;
    float S[32];
#pragma unroll
    for (int i = 0; i < 32; ++i) S[i] = S0 ? S0[(size_t)(32 * kg + i) * 128 + v] : 0.f;
    const float nw = p.in[I_DNW][l * 128 + v];
    const int qcol = (tid < 128) ? (h * 128 + tid) : (512 + h * 128 + (tid - 128));
    float pre = 0.f;
    if (tid < 256) { qk[tid] = bf2f(c.QKVN[(size_t)(row0 - MP) * 1536 + qcol]); if (ntok > 1) pre = bf2f(c.QKVN[(size_t)(row0 + 1 - MP) * 1536 + qcol]); }
    __syncthreads();
    float o_prev = 0.f;
    for (int t = 0; t < ntok; ++t) {
        const int row = row0 + t;
        const LAS float* cur = qk + (t & 1) * 256;
        const float vv = bf2f(c.QKVN[(size_t)(row - MP) * 1536 + 1024 + h * 128 + v]);
        const float g = c.GB[(size_t)(row - MP) * 8 + h], beta = c.GB[(size_t)(row - MP) * 8 + 4 + h];
        float r0 = 0.f, r1 = 0.f, r2 = 0.f, r3 = 0.f;
#pragma unroll
        for (int i = 0; i < 32; i += 4) { const f32x4 kk = *(const LAS f32x4*)(cur + 128 + 32 * kg + i);
            r0 += kk[0] * S[i]; r1 += kk[1] * S[i + 1]; r2 += kk[2] * S[i + 2]; r3 += kk[3] * S[i + 3]; }
        rpart[kg * 128 + v] = (r0 + r1) + (r2 + r3);
        if (tid < 256) { qk[((t + 1) & 1) * 256 + tid] = pre; if (t + 2 < ntok) pre = bf2f(c.QKVN[(size_t)(row + 2 - MP) * 1536 + qcol]); }
        __syncthreads();
        const float r = (rpart[v] + rpart[128 + v]) + (rpart[256 + v] + rpart[384 + v]);
        const float eg = __expf(g), dd = beta * (vv - eg * r);
        float o0 = 0.f, o1 = 0.f, o2 = 0.f, o3 = 0.f;
#pragma unroll
        for (int i = 0; i < 32; i += 4) { const f32x4 kk = *(const LAS f32x4*)(cur + 128 + 32 * kg + i), qq = *(const LAS f32x4*)(cur + 32 * kg + i);
            S[i] = eg * S[i] + kk[0] * dd; S[i + 1] = eg * S[i + 1] + kk[1] * dd; S[i + 2] = eg * S[i + 2] + kk[2] * dd; S[i + 3] = eg * S[i + 3] + kk[3] * dd;
            o0 += qq[0] * S[i]; o1 += qq[1] * S[i + 1]; o2 += qq[2] * S[i + 2]; o3 += qq[3] * S[i + 3]; }
        opart[kg * 128 + v] = (o0 + o1) + (o2 + o3);
        if (tid < 128 && t > 0) {
            const float ss = ssb[((t - 1) & 1) * 2] + ssb[((t - 1) & 1) * 2 + 1];
            const float rs = rsqrtf(ss * (1.f / 128.f) + 1e-6f);
            const float z = bf2f(c.PROJ[(size_t)(row - 1) * NPROJ + C_Z + h * 128 + v]);
            c.OAB[(size_t)(row - 1) * D + h * 128 + v] = (bf16_t)f2bf(o_prev * rs * nw * siluf_(z));
        }
        __syncthreads();
        if (tid < 128) { o_prev = (opart[v] + opart[128 + v]) + (opart[256 + v] + opart[384 + v]); const float s2 = wave_sum(o_prev * o_prev); if (lane == 0) ssb[(t & 1) * 2 + wave] = s2; }
    }
    __syncthreads();
    if (tid < 128) {
        const int t = ntok - 1, row = row0 + t;
        const float ss = ssb[(t & 1) * 2] + ssb[(t & 1) * 2 + 1];
        const float rs = rsqrtf(ss * (1.f / 128.f) + 1e-6f);
        const float z = bf2f(c.PROJ[(size_t)row * NPROJ + C_Z + h * 128 + v]);
        c.OAB[(size_t)row * D + h * 128 + v] = (bf16_t)f2bf(o_prev * rs * nw * siluf_(z));
    }
#pragma unroll
    for (int i = 0; i < 32; ++i) Sout[(size_t)(32 * kg + i) * 128 + v] = S[i];
    __syncthreads();
}

DEV void ffn_fix(const Ctx& c, int l) {
    const Params& p = *c.p;
    const bf16_t* RAWG = (const bf16_t*)(c.ws + WS_RAWG); const bf16_t* RAWU = (const bf16_t*)(c.ws + WS_RAWU);
    const int GT = c.G * 512;
    for (int idx = c.bid * 512 + c.tid; idx < (MP / 64) * 2 * 384; idx += GT) {
        const int cg_ = idx % 384, rr = (idx / 384) & 1, grp = idx / 768, f0 = cg_ * 8, row = grp * 64 + rr;
        const bool seqstart = (grp & 31) == 0;
        float w0[8], w1[8], w2[8], g0[8], g1[8], g2[8], u[8], o[8];
        { const float* fw = p.in[I_FCW] + (size_t)l * 3 * DFF + f0;
#pragma unroll
          for (int e = 0; e < 8; ++e) { w0[e] = fw[e]; w1[e] = fw[DFF + e]; w2[e] = fw[2 * DFF + e]; g1[e] = 0.f; g2[e] = 0.f; } }
        unpack8(*(const u32x4*)(RAWG + (size_t)(grp * 4 + rr) * DFF + f0), g0);
        unpack8(*(const u32x4*)(RAWU + (size_t)(grp * 2 + rr) * DFF + f0), u);
        if (rr) { unpack8(*(const u32x4*)(RAWG + (size_t)(grp * 4) * DFF + f0), g1); if (!seqstart) unpack8(*(const u32x4*)(RAWG + (size_t)((grp - 1) * 4 + 3) * DFF + f0), g2); }
        else if (!seqstart) { unpack8(*(const u32x4*)(RAWG + (size_t)((grp - 1) * 4 + 3) * DFF + f0), g1); unpack8(*(const u32x4*)(RAWG + (size_t)((grp - 1) * 4 + 2) * DFF + f0), g2); }
#pragma unroll
        for (int e = 0; e < 8; ++e) o[e] = gelu_t(w0[e] * g2[e] + w1[e] * g1[e] + w2[e] * g0[e]) * u[e];
        *(u32x4*)(c.HB + (size_t)row * DFF + f0) = pack8(o);
        if ((grp & 31) == 31) {
            float gl_[8]; unpack8(*(const u32x4*)(RAWG + (size_t)(grp * 4 + 2 + rr) * DFF + f0), gl_);
            float* dst = p.out + O_PFC + ((size_t)(l * NBATCH + (grp >> 5)) * 2 + rr) * DFF + f0;
            *(f32x4*)dst = (f32x4){gl_[0], gl_[1], gl_[2], gl_[3]}; *(f32x4*)(dst + 4) = (f32x4){gl_[4], gl_[5], gl_[6], gl_[7]};
        }
    }
}

DEV void sample_fixup(const Ctx& c) {
    const int gw = c.bid * 8 + c.wave, NGW = c.G * 8;
    const float* Z = (const float*)(c.ws + WS_Z);
    for (int r = gw; r < MS; r += NGW) {
        const int row = MP + r; float ss = 0.f;
#pragma unroll
        for (int j = 0; j < 4; ++j) {
            const size_t o = (size_t)r * D + j * 256 + c.lane * 4;
            const f32x4 z = (*(const f32x4*)(Z + o) + *(const f32x4*)(Z + (size_t)MS * D + o)) + *(const f32x4*)(Z + (size_t)2 * MS * D + o);
            const u32x2 xi = *(const u32x2*)(c.XB + (size_t)row * D + j * 256 + c.lane * 4);
            const float x0 = __uint_as_float(xi.x << 16) + z[0], x1 = __uint_as_float(xi.x & 0xffff0000u) + z[1], x2 = __uint_as_float(xi.y << 16) + z[2], x3 = __uint_as_float(xi.y & 0xffff0000u) + z[3];
            u32x2 w; w.x = pk2(x0, x1); w.y = pk2(x2, x3); *(u32x2*)(c.XB + (size_t)row * D + j * 256 + c.lane * 4) = w;
            const float r0 = __uint_as_float(w.x << 16), r1 = __uint_as_float(w.x & 0xffff0000u), r2 = __uint_as_float(w.y << 16), r3 = __uint_as_float(w.y & 0xffff0000u);
            ss += (r0 * r0 + r1 * r1) + (r2 * r2 + r3 * r3);
        }
        ss = wave_sum(ss);
        if (c.lane < NSLOT) c.SSQ[(size_t)row * NSLOT + c.lane] = (c.lane == 0) ? ss : 0.f;
    }
}

DEV void final_norm(const Ctx& c) {
    const int gw = c.bid * 8 + c.wave, NGW = c.G * 8;
    const float* fw = c.p->in[I_FNW];
    for (int row = gw; row < M; row += NGW) {
        float s = 0.f;
#pragma unroll
        for (int k = 0; k < NSLOT; ++k) s += c.SSQ[(size_t)row * NSLOT + k];
        const float rs = rsqrtf(s * (1.f / 1024.f) + 1e-6f);
#pragma unroll
        for (int j = 0; j < 4; ++j) { const u32x2 xi = *(const u32x2*)(c.XB + (size_t)row * D + j * 256 + c.lane * 4); const f32x4 w = *(const f32x4*)(fw + j * 256 + c.lane * 4);
            const f32x4 v = {__uint_as_float(xi.x << 16), __uint_as_float(xi.x & 0xffff0000u), __uint_as_float(xi.y << 16), __uint_as_float(xi.y & 0xffff0000u)};
            *(f32x4*)(c.p->out + (size_t)row * D + j * 256 + c.lane * 4) = v * rs * w; }
    }
}

__global__ void __launch_bounds__(512, 2) mega(Params prm) {
    extern __shared__ __attribute__((aligned(16))) unsigned char lds_raw[];
    LAS unsigned char* lds = (LAS unsigned char*)lds_raw;
    cg::grid_group grid = cg::this_grid();
    volatile LAS unsigned* bst = (volatile LAS unsigned*)(lds + 147200);
    if (threadIdx.x < 2) bst[threadIdx.x] = 0u;
    __syncthreads();
    const XcdBarrier xbar = xcd_barrier_post((unsigned*)prm.ws, bst);

    { const Ctx c = mk(prm); convert_layer(c, 0, c.bid * 8 + c.wave, c.G * 8, lds); x_prologue(c); }
    grid.sync();

    for (int l = 0; l < DEPTH; ++l) {
        { const Ctx c = mk(prm); unsigned char* wb = wbuf(c, l);
          pg8::Gemm g{c.XB, (const bf16_t*)(wb + WO_WIN), D, D, D}; pg8::StaticOrder S; S.init(M, NPROJ, c.G, c.bid);
          pg8::EpiScaleBf16 E{c.PROJ, NPROJ, c.SSQ};
          pg8::gemm_phase<pg8::EpiScaleBf16, pg8::StaticOrder, 0>(lds, g, S, E); }
        xcd_barrier(xbar);
        { const Ctx c = mk(prm); for (int it = c.bid; it < NBATCH * 32 * 4; it += c.G) dn_chunk_prep(c, l, it, lds); }
        { const Ctx c = mk(prm); lru_items(c, l, c.bid, c.G, (MP / 64) * 4, 0, lds); }
        { const Ctx c = mk(prm); dn_prep_rows(c, l); }
        xcd_barrier(xbar);
        { const Ctx c = mk(prm);
        if (c.bid < 32) {
            dn_chunk_scan(c, l, c.bid >> 2, c.bid & 3, lds);
        } else {
            const int nb = c.G - 32, ob = c.bid - 32;
            lru_items(c, l, ob, nb, (M / 64) * 4, 1, lds);
            for (int it = ob; it < SBATCH * 4; it += nb) { const int sb = it >> 2, h = it & 3; const size_t so = (size_t)((l * SBATCH + sb) * 4 + h) * 16384;
                dn_scan_item(c, l, MP + sb * 4, 4, h, prm.in[I_SDN] + so, prm.out + O_SDN + so, lds); }
        } }
        xcd_barrier(xbar);
        { const Ctx c = mk(prm); unsigned char* wb = wbuf(c, l);
          pg8::Gemm g{c.OAB, (const bf16_t*)(wb + WO_WAB), D, D, 512}; pg8::TwoHalfOrder S; S.init(M, D, c.G, c.bid);
          pg8::EpiMerge E{c.MERGED, c.PROJ};
          pg8::gemm_phase<pg8::EpiMerge, pg8::TwoHalfOrder, 1>(lds, g, S, E); }
        xcd_barrier(xbar);
        { const Ctx c = mk(prm); unsigned char* wb = wbuf(c, l);
          pg8::Gemm g{c.MERGED, (const bf16_t*)(wb + WO_WO), D, D, D}; pg8::StaticOrder S; S.init(M, D, c.G, c.bid);
          pg8::EpiResid E{c.XB, c.SSQ};
          pg8::gemm_phase<pg8::EpiResid, pg8::StaticOrder, 0>(lds, g, S, E); }
        xcd_barrier(xbar);
        { const Ctx c = mk(prm); unsigned char* wb = wbuf(c, l);
          pg8::Gemm g{c.XB, (const bf16_t*)(wb + WO_WFF), D, D, D}; pg8::StaticOrder S; S.init(M, 2 * DFF, c.G, c.bid);
          pg8::EpiAct E{c.HB, c.SSQ, (bf16_t*)(c.ws + WS_RAWG), (bf16_t*)(c.ws + WS_RAWU), prm.in[I_FCW] + (size_t)l * 3 * DFF, prm.in[I_SFC] + (size_t)l * SBATCH * 2 * DFF, prm.out + O_SFC + (size_t)l * SBATCH * 2 * DFF};
          pg8::gemm_phase<pg8::EpiAct, pg8::StaticOrder, 0>(lds, g, S, E); }
        xcd_barrier(xbar);
        { const Ctx c = mk(prm); ffn_fix(c, l); }
        xcd_barrier(xbar);
        { const Ctx c = mk(prm); unsigned char* wb = wbuf(c, l);
          pg8::Gemm g{c.HB, (const bf16_t*)(wb + WO_WDN), DFF, DFF, DFF}; pg8::StaticOrder S; S.init(MP, D, c.G, c.bid);
          pg8::EpiResid E{c.XB, c.SSQ};
          pg8::gemm_phase<pg8::EpiResid, pg8::StaticOrder, 0>(lds, g, S, E); }
        { const Ctx c = mk(prm); unsigned char* wb = wbuf(c, l);
          pg8::Gemm g{c.HB, (const bf16_t*)(wb + WO_WDN), DFF, DFF, 1024}; pg8::SampleSplitOrder S{c.G, c.bid};
          pg8::EpiPartial E{(float*)(c.ws + WS_Z)};
          pg8::gemm_phase<pg8::EpiPartial, pg8::SampleSplitOrder, 2>(lds, g, S, E);
          if (l + 1 < DEPTH && c.bid >= 24) convert_layer(c, l + 1, (c.bid - 24) * 8 + c.wave, (c.G - 24) * 8, lds); }
        xcd_barrier(xbar);
        { const Ctx c = mk(prm); sample_fixup(c); }
        xcd_barrier(xbar);
    }
    { const Ctx c = mk(prm); final_norm(c); }
}

extern "C" void kernel_launch(void* const* d_in, const int* in_sizes, int n_in, void* d_out, int out_size, void* d_ws, size_t ws_size, hipStream_t stream) {
    static int grid = 0;
    if (grid == 0) {
        if (n_in != 28 || (size_t)out_size != O_END || ws_size < WS_END) { fprintf(stderr, "kernel_launch: unexpected shapes n_in %d out %d ws %zu\n", n_in, out_size, ws_size); grid = -1; return; }
        int dev = 0, cus = 0, per_cu = 0;
        (void)hipGetDevice(&dev);
        (void)hipDeviceGetAttribute(&cus, hipDeviceAttributeMultiprocessorCount, dev);
        (void)hipFuncSetAttribute((const void*)mega, hipFuncAttributeMaxDynamicSharedMemorySize, LDS_BYTES);
        (void)hipOccupancyMaxActiveBlocksPerMultiprocessor(&per_cu, (const void*)mega, 512, LDS_BYTES);
        fprintf(stderr, "kernel_launch: cus %d per_cu %d ws %zu\n", cus, per_cu, ws_size);
        grid = cus;
    }
    if (grid < 0) return;
    (void)hipMemsetAsync(d_ws, 0, 16384, stream);
    Params p{};
    for (int i = 0; i < 28; ++i) p.in[i] = (const float*)d_in[i];
    p.out = (float*)d_out; p.ws = (unsigned char*)d_ws;
    void* args[] = {&p};
    hipError_t e = hipLaunchCooperativeKernel((const void*)mega, dim3(grid), dim3(512), args, LDS_BYTES, stream);
    if (e != hipSuccess) fprintf(stderr, "kernel_launch: cooperative launch failed: %s\n", hipGetErrorString(e));
}
```

```cpp
#include <hip/hip_runtime.h>
#include <hip/hip_cooperative_groups.h>
#include <cstdio>
#include <cstdint>
namespace cg = cooperative_groups;

#define LAS __attribute__((address_space(3)))
#define DEV __device__ __forceinline__
typedef unsigned short bf16_t;
typedef short bf16x8 __attribute__((ext_vector_type(8)));
typedef float f32x4 __attribute__((ext_vector_type(4)));
typedef float f32x2 __attribute__((ext_vector_type(2)));
typedef unsigned u32x4 __attribute__((ext_vector_type(4)));
typedef unsigned u32x2 __attribute__((ext_vector_type(2)));

constexpr int D = 1024, NBATCH = 8, SEQ = 2048, DEPTH = 4, SBATCH = 128, SSEQ = 4;
constexpr int MP = NBATCH * SEQ, MS = SBATCH * SSEQ, M = MP + MS;
constexpr int NPROJ = 5376;
constexpr int DFF = 3072;
constexpr int NSLOT = 16;
constexpr int C_QKV = 0, C_Z = 1536, C_LX = 2048, C_LY = 2560, C_GA = 3072, C_GB = 4096, C_AIN = 5120, C_BIN = 5124;
constexpr size_t O_YP = 0, O_YS = 16777216, O_PDC = 17301504, O_PDN = 17448960, O_PLC = 19546112, O_PL = 19595264, O_PFC = 19611648,
                 O_SDC = 19808256, O_SDN = 22167552, O_SLC = 55721984, O_SL = 56508416, O_SFC = 56770560, O_END = 59916288;
constexpr size_t MiB = 1u << 20;
constexpr size_t WS_SSQ = 1 * MiB, WS_GB = 3 * MiB, WS_WB = 4 * MiB, WB_STRIDE = 34 * MiB;
constexpr size_t WS_XF = 72 * MiB, WS_XB = 138 * MiB, WS_PROJ = 171 * MiB, WS_QKVN = 345 * MiB, WS_WP = 347 * MiB, WS_QGP = 363 * MiB, WS_KDP = 379 * MiB, WS_UTP = 395 * MiB, WS_ATP = 411 * MiB;
constexpr size_t WS_CSA = 419 * MiB, WS_CSH = 420 * MiB, WS_GL = 420 * MiB + 786432, WS_OAB = 421 * MiB;
constexpr size_t WS_MERGED = 347 * MiB, WS_HB = 171 * MiB, WS_Z = 454 * MiB, WS_RAWG = 460 * MiB, WS_RAWU = 467 * MiB, WS_END = 471 * MiB;
constexpr size_t WO_WIN = 0, WO_WAB = 11 * MiB, WO_WO = 13 * MiB, WO_WFF = 15 * MiB, WO_WDN = 27 * MiB, WO_LWA = 33 * MiB, WO_LWX = 33 * MiB + 131072;
constexpr int LDS_BYTES = 147456;

DEV float bf2f(unsigned short b) { return __uint_as_float(((unsigned)b) << 16); }
DEV unsigned f2bf(float f) { unsigned u = __float_as_uint(f); return (u + 0x7fffu + ((u >> 16) & 1u)) >> 16; }
DEV unsigned pk2(float lo, float hi) { return f2bf(lo) | (f2bf(hi) << 16); }
DEV float sigm(float x) { return 1.f / (1.f + __expf(-x)); }
DEV float siluf_(float x) { return x / (1.f + __expf(-x)); }
DEV float gelu_t(float x) { const float u = 1.5957691216f * (x + 0.044715f * x * x * x); return x / (1.f + __expf(-u)); }
DEV float neg_expm1(float x) {
    const float pz = x * (1.f + x * (0.5f + x * (0.16666667f + x * (0.041666668f + x * (0.0083333338f + x * 0.0013888889f)))));
    return x > -0.3f ? -pz : 1.f - __expf(x);
}
DEV float softplus_(float x) { return fmaxf(x, 0.f) + log1pf(__expf(-fabsf(x))); }
DEV float wave_sum(float v) {
#pragma unroll
    for (int o = 1; o < 64; o <<= 1) v += __shfl_xor(v, o);
    return v;
}
DEV void unpack8(const u32x4 w, float (&f)[8]) {
    f[0] = __uint_as_float(w.x << 16); f[1] = __uint_as_float(w.x & 0xffff0000u); f[2] = __uint_as_float(w.y << 16); f[3] = __uint_as_float(w.y & 0xffff0000u);
    f[4] = __uint_as_float(w.z << 16); f[5] = __uint_as_float(w.z & 0xffff0000u); f[6] = __uint_as_float(w.w << 16); f[7] = __uint_as_float(w.w & 0xffff0000u);
}
DEV u32x4 pack8(const float (&f)[8]) { u32x4 w; w.x = pk2(f[0], f[1]); w.y = pk2(f[2], f[3]); w.z = pk2(f[4], f[5]); w.w = pk2(f[6], f[7]); return w; }

struct Params { const float* in[28]; float* out; unsigned char* ws; };
enum { I_XP = 0, I_XS, I_SDC, I_SDN, I_SLC, I_SL, I_SFC, I_N1, I_WIN, I_DCW, I_ALOG, I_DTB, I_DNW, I_LCW, I_LCB, I_LWA, I_LBA, I_LWX, I_LBX, I_LAM, I_WBA, I_WBB, I_WO, I_N2, I_WFF, I_FCW, I_WDN, I_FNW };

namespace pg8 {
constexpr int BM = 256, BK = 64, HALF = 128, HTB = HALF * BK * 2, STAGE_BYTES = 8 * HTB, NXCD = 8, WGM = 8;
__host__ __device__ __forceinline__ int lds_byte(int r, int c) { const int st = (r >> 4) * 2 + (c >> 5), rr = r & 15, cc = c & 31, ob = rr * 64 + cc * 2; return st * 1024 + (ob ^ (((ob >> 9) & 1) << 5)); }
__host__ __device__ __forceinline__ void stage_rc(int b, int& R, int& C) { const int st = b / 1024, sb = b % 1024, swz = sb ^ (((sb >> 9) & 1) << 5); R = (st >> 1) * 16 + swz / 64; C = (st & 1) * 32 + (swz % 64) / 2; }
__host__ __device__ __forceinline__ int perm32(int rho) { const int n = rho >> 4, i = rho & 15; return 8 * (i >> 2) + 4 * n + (i & 3); }
struct Unit { int pm, pn, kh; };
struct Gemm { const bf16_t* A; const bf16_t* Bt; int lda, ldb, K; };
struct StaticOrder {
    int nM, nN, nwg, G, c;
    __device__ void init(int M_, int N_, int G_, int c_) { nM = M_ / BM; nN = N_ / BM; nwg = nM * nN; G = G_; c = c_; }
    __device__ bool next(int i, Unit& u) const {
        const long L = (long)i * G + c; if (L >= nwg) return false;
        int wgid = (int)L; { const int q = nwg / NXCD, r = nwg % NXCD, xcd = wgid % NXCD, off = wgid / NXCD; wgid = (xcd < r ? xcd * (q + 1) : r * (q + 1) + (xcd - r) * q) + off; }
        const int nig = WGM * nN, gid = wgid / nig, fm = gid * WGM, gsz = (nM - fm) < WGM ? (nM - fm) : WGM;
        u.pm = fm + ((wgid % nig) % gsz); u.pn = (wgid % nig) / gsz; u.kh = 0; return true;
    }
};
struct TwoHalfOrder : StaticOrder {
    __device__ bool next(int i, Unit& u) const { if (!StaticOrder::next(i >> 1, u)) return false; u.kh = i & 1; return true; }
};
struct SampleSplitOrder {
    int G, c;
    __device__ bool next(int i, Unit& u) const { const int L = i * G + c; if (L >= 24) return false; const int rem = L % 12; u.pm = MP / BM + L / 12; u.pn = rem / 3; u.kh = rem % 3; return true; }
};
DEV unsigned cvt_pk_bf16(float lo, float hi) { unsigned r; asm volatile("v_cvt_pk_bf16_f32 %0, %1, %2" : "=v"(r) : "v"(lo), "v"(hi)); return r; }

template <class Epi, class Sched, int MODE>
DEV void gemm_phase(LAS unsigned char* lds, const Gemm g, const Sched& S, const Epi& E) {
    int tid = threadIdx.x; asm volatile("" : "+v"(tid));
    const int wid = __builtin_amdgcn_readfirstlane(tid >> 6), lane = tid & 63, wr = wid >> 2, wc = wid & 3, fr = lane & 15, fq = lane >> 4;
    const int K = g.K, nt = K / BK;
    unsigned voffA[2], voffB[2];
#pragma unroll
    for (int i = 0; i < 2; ++i) { int R, C; stage_rc(tid * 16 + i * 8192, R, C); const int Rb = Epi::PERM ? ((R & ~31) + perm32(R & 31)) : R;
        voffA[i] = (unsigned)(R * g.lda + C) * 2u; voffB[i] = (unsigned)(Rb * g.ldb + C) * 2u; }
    const size_t kstep = (size_t)(BK * 2);
    const size_t hstepA = (size_t)HALF * g.lda * 2, hstepB = (size_t)HALF * g.ldb * 2;
    const size_t tstepA = 2 * hstepA, tstepB = 2 * hstepB;
    const unsigned ldsw = (unsigned)wid * 1024u;
    const int aoff = lds_byte(wr * 64 + fr, fq * 8), boff = lds_byte(wc * 32 + fr, fq * 8);
#define PG8_SA(b, h) (((b) * 2 + (h)) * HTB)
#define PG8_SB(b, h) ((4 + (b) * 2 + (h)) * HTB)
#define PG8_STAGE(bufoff, gbase, voff) do { _Pragma("unroll") for (int _i = 0; _i < 2; ++_i) \
        __builtin_amdgcn_global_load_lds((const unsigned*)((const char*)(gbase) + (voff)[_i]), (LAS unsigned*)(lds + (bufoff) + ldsw + _i * 8192), 16, 0, 0); } while (0)
#define PG8_LDA(dst, b, h) do { _Pragma("unroll") for (int m = 0; m < 4; ++m) _Pragma("unroll") for (int k = 0; k < 2; ++k) dst[m][k] = *(const LAS bf16x8*)(lds + PG8_SA(b, h) + aoff + m * 2048 + k * 1024); } while (0)
#define PG8_LDB(dst, b, h) do { _Pragma("unroll") for (int n = 0; n < 2; ++n) _Pragma("unroll") for (int k = 0; k < 2; ++k) dst[n][k] = *(const LAS bf16x8*)(lds + PG8_SB(b, h) + boff + n * 2048 + k * 1024); } while (0)
#define PG8_MMA(ai, bj, At, Bt) do { __builtin_amdgcn_s_setprio(1); _Pragma("unroll") for (int m = 0; m < 4; ++m) _Pragma("unroll") for (int n = 0; n < 2; ++n) _Pragma("unroll") for (int k = 0; k < 2; ++k) \
        acc[ai][bj][m][n] = __builtin_amdgcn_mfma_f32_16x16x32_bf16(Bt[n][k], At[m][k], acc[ai][bj][m][n], 0, 0, 0); __builtin_amdgcn_s_setprio(0); } while (0)
#define PG8_WAIT_V(n) asm volatile("s_waitcnt vmcnt(" #n ")" ::: "memory")
#define PG8_WAIT_L(n) asm volatile("s_waitcnt lgkmcnt(" #n ")" ::: "memory")
#define PG8_BAR __builtin_amdgcn_s_barrier()
#define PG8_SCHED __builtin_amdgcn_sched_barrier(0)
    Unit cur, nxt; int ui = 0;
    if (!S.next(0, cur)) return;
    f32x4 acc[2][2][4][2];
#pragma unroll
    for (int a = 0; a < 2; ++a)
#pragma unroll
        for (int b = 0; b < 2; ++b)
#pragma unroll
            for (int m = 0; m < 4; ++m)
#pragma unroll
                for (int n = 0; n < 2; ++n) acc[a][b][m][n] = (f32x4){0.f, 0.f, 0.f, 0.f};
    bf16x8 At[4][2], B0[2][2], B1[2][2];
    const size_t khstep = MODE ? (size_t)K * 2 : 0;
    const char* cA = (const char*)g.A + (size_t)cur.pm * tstepA + cur.kh * khstep; const char* cB = (const char*)g.Bt + (size_t)cur.pn * tstepB + cur.kh * khstep;
    PG8_STAGE(PG8_SB(0, 0), cB, voffB); PG8_STAGE(PG8_SB(0, 1), cB + hstepB, voffB); PG8_STAGE(PG8_SA(0, 0), cA, voffA); PG8_STAGE(PG8_SA(0, 1), cA + hstepA, voffA);
    if (wr == 1) PG8_BAR;
    PG8_WAIT_V(2); PG8_BAR;
    PG8_STAGE(PG8_SB(1, 0), cB + kstep, voffB); PG8_STAGE(PG8_SA(1, 0), cA + kstep, voffA); PG8_STAGE(PG8_SB(1, 1), cB + hstepB + kstep, voffB);
    PG8_WAIT_V(6); PG8_BAR;
    for (;;) {
        const bool has_next = S.next(ui + 1, nxt);
        const char* nA = has_next ? (const char*)g.A + (size_t)nxt.pm * tstepA + nxt.kh * khstep : cA; const char* nB = has_next ? (const char*)g.Bt + (size_t)nxt.pn * tstepB + nxt.kh * khstep : cB;
        for (int t = 0; t < nt; t += 2) {
            const bool last = (t == nt - 2);
            const char* a1 = cA + (size_t)(t + 1) * kstep;
            const char* a2 = last ? nA : cA + (size_t)(t + 2) * kstep; const char* b2 = last ? nB : cB + (size_t)(t + 2) * kstep;
            const char* a3 = a2 + kstep; const char* b3 = b2 + kstep;
            PG8_LDB(B0, 0, 0); PG8_LDB(B1, 0, 1); PG8_SCHED; PG8_LDA(At, 0, 0); PG8_STAGE(PG8_SA(1, 1), a1 + hstepA, voffA);
            PG8_WAIT_V(8); PG8_WAIT_L(0); PG8_BAR; PG8_MMA(0, 0, At, B0); PG8_MMA(0, 1, At, B1); PG8_BAR; PG8_SCHED;
            PG8_LDA(At, 0, 1); PG8_STAGE(PG8_SB(0, 0), b2, voffB); PG8_STAGE(PG8_SB(0, 1), b2 + hstepB, voffB); PG8_STAGE(PG8_SA(0, 0), a2, voffA);
            PG8_WAIT_V(8); PG8_WAIT_L(0); PG8_BAR; PG8_MMA(1, 0, At, B0); PG8_MMA(1, 1, At, B1); PG8_BAR; PG8_SCHED;
            PG8_LDB(B0, 1, 0); PG8_LDB(B1, 1, 1); PG8_SCHED; PG8_LDA(At, 1, 0); PG8_STAGE(PG8_SA(0, 1), a2 + hstepA, voffA);
            PG8_WAIT_V(8); PG8_WAIT_L(0); PG8_BAR; PG8_MMA(0, 0, At, B0); PG8_MMA(0, 1, At, B1); PG8_BAR; PG8_SCHED;
            PG8_LDA(At, 1, 1); PG8_STAGE(PG8_SB(1, 0), b3, voffB); PG8_STAGE(PG8_SB(1, 1), b3 + hstepB, voffB); PG8_STAGE(PG8_SA(1, 0), a3, voffA);
            PG8_WAIT_V(8); PG8_WAIT_L(0); PG8_BAR; PG8_MMA(1, 0, At, B0); PG8_MMA(1, 1, At, B1); PG8_BAR; PG8_SCHED;
        }
        if (wr == 0) PG8_BAR;
        E(acc, cur, wr, wc, fr, fq);
        if (!has_next) break;
        if (!(MODE == 1 && cur.kh == 0)) {
#pragma unroll
        for (int a = 0; a < 2; ++a)
#pragma unroll
            for (int b = 0; b < 2; ++b)
#pragma unroll
                for (int m = 0; m < 4; ++m)
#pragma unroll
                    for (int n = 0; n < 2; ++n) acc[a][b][m][n] = (f32x4){0.f, 0.f, 0.f, 0.f};
        }
        cur = nxt; cA = nA; cB = nB; ++ui;
        if (wr == 1) PG8_BAR;
    }
    PG8_WAIT_V(0);
    PG8_BAR;
#undef PG8_SA
#undef PG8_SB
#undef PG8_STAGE
#undef PG8_LDA
#undef PG8_LDB
#undef PG8_MMA
#undef PG8_WAIT_V
#undef PG8_WAIT_L
#undef PG8_BAR
#undef PG8_SCHED
}

struct EpiScaleBf16 {
    static constexpr bool PERM = true;
    bf16_t* O; int ldc; const float* ssq;
    DEV void operator()(const f32x4 (&acc)[2][2][4][2], const Unit& u, int wr, int wc, int fr, int fq) const {
        const int row0 = u.pm * BM + wr * 64 + fr, col0 = u.pn * BM + wc * 32 + 8 * fq;
#pragma unroll
        for (int ai = 0; ai < 2; ++ai) {
            f32x4 sv[4][4];
#pragma unroll
            for (int i = 0; i < 4; ++i)
#pragma unroll
                for (int k = 0; k < 4; ++k) sv[i][k] = *(const f32x4*)(ssq + (size_t)(row0 + ai * HALF + i * 16) * NSLOT + 4 * k);
#pragma unroll
            for (int m = 0; m < 4; ++m) {
                const int row = row0 + ai * HALF + m * 16;
                const f32x4 s4 = (sv[m][0] + sv[m][1]) + (sv[m][2] + sv[m][3]);
                const float s = (s4[0] + s4[1]) + (s4[2] + s4[3]);
                const float rs = rsqrtf(s * (1.f / 1024.f) + 1e-6f);
                bf16_t* rowp = O + (size_t)row * ldc + col0;
#pragma unroll
                for (int bj = 0; bj < 2; ++bj) { const f32x4 v0 = acc[ai][bj][m][0] * rs, v1 = acc[ai][bj][m][1] * rs;
                    u32x4 w; w.x = cvt_pk_bf16(v0[0], v0[1]); w.y = cvt_pk_bf16(v0[2], v0[3]); w.z = cvt_pk_bf16(v1[0], v1[1]); w.w = cvt_pk_bf16(v1[2], v1[3]);
                    *(u32x4*)(rowp + bj * HALF) = w; }
            }
        }
    }
};
struct EpiMerge {
    static constexpr bool PERM = true;
    bf16_t* O; const bf16_t* P;
    DEV void mid(f32x4 (&acc)[2][2][4][2], const Unit& u, int wr, int wc, int fr, int fq) const {
        const int row0 = u.pm * BM + wr * 64 + fr, col0 = u.pn * BM + wc * 32 + 8 * fq;
#pragma unroll
        for (int ai = 0; ai < 2; ++ai) {
            u32x4 ra[4][2], rb[4][2];
#pragma unroll
            for (int m = 0; m < 4; ++m)
#pragma unroll
                for (int bj = 0; bj < 2; ++bj) { const bf16_t* rowp = P + (size_t)(row0 + ai * HALF + m * 16) * NPROJ + col0 + bj * HALF;
                    ra[m][bj] = *(const u32x4*)(rowp + C_GA); rb[m][bj] = *(const u32x4*)(rowp + C_GB); }
#pragma unroll
            for (int m = 0; m < 4; ++m)
#pragma unroll
                for (int bj = 0; bj < 2; ++bj) {
                    float ga[8], gb[8]; unpack8(ra[m][bj], ga); unpack8(rb[m][bj], gb);
#pragma unroll
                    for (int e = 0; e < 8; ++e) { const float ratio = (1.f + __expf(-gb[e])) / (1.f + __expf(-ga[e])); acc[ai][bj][m][e >> 2][e & 3] *= ratio; }
                }
        }
    }
    DEV void operator()(f32x4 (&acc)[2][2][4][2], const Unit& u, int wr, int wc, int fr, int fq) const {
        if (u.kh == 0) { mid(acc, u, wr, wc, fr, fq); return; }
        const int row0 = u.pm * BM + wr * 64 + fr, col0 = u.pn * BM + wc * 32 + 8 * fq;
#pragma unroll
        for (int ai = 0; ai < 2; ++ai) {
            u32x4 rb[4][2];
#pragma unroll
            for (int m = 0; m < 4; ++m)
#pragma unroll
                for (int bj = 0; bj < 2; ++bj) rb[m][bj] = *(const u32x4*)(P + (size_t)(row0 + ai * HALF + m * 16) * NPROJ + col0 + C_GB + bj * HALF);
#pragma unroll
            for (int m = 0; m < 4; ++m) {
                const int row = row0 + ai * HALF + m * 16;
#pragma unroll
                for (int bj = 0; bj < 2; ++bj) {
                    float gb[8]; unpack8(rb[m][bj], gb);
                    float o[8];
#pragma unroll
                    for (int e = 0; e < 8; ++e) o[e] = acc[ai][bj][m][e >> 2][e & 3] / (1.f + __expf(-gb[e]));
                    u32x4 w; w.x = cvt_pk_bf16(o[0], o[1]); w.y = cvt_pk_bf16(o[2], o[3]); w.z = cvt_pk_bf16(o[4], o[5]); w.w = cvt_pk_bf16(o[6], o[7]);
                    *(u32x4*)(O + (size_t)row * D + col0 + bj * HALF) = w;
                }
            }
        }
    }
};
struct EpiResid {
    static constexpr bool PERM = false;
    bf16_t* XB; float* ssq;
    DEV void operator()(const f32x4 (&acc)[2][2][4][2], const Unit& u, int wr, int wc, int fr, int fq) const {
        const int row0 = u.pm * BM + wr * 64 + fr, col0 = u.pn * BM + wc * 32 + 4 * fq;
#pragma unroll
        for (int ai = 0; ai < 2; ++ai) {
            u32x2 xin[4][2][2];
#pragma unroll
            for (int m = 0; m < 4; ++m)
#pragma unroll
                for (int bj = 0; bj < 2; ++bj)
#pragma unroll
                    for (int n = 0; n < 2; ++n) xin[m][bj][n] = *(const u32x2*)(XB + (size_t)(row0 + ai * HALF + m * 16) * D + col0 + bj * HALF + n * 16);
#pragma unroll
            for (int m = 0; m < 4; ++m) {
                const int row = row0 + ai * HALF + m * 16;
                bf16_t* br = XB + (size_t)row * D + col0;
                float ss = 0.f;
#pragma unroll
                for (int bj = 0; bj < 2; ++bj)
#pragma unroll
                    for (int n = 0; n < 2; ++n) {
                        const u32x2 xi = xin[m][bj][n];
                        const float x0 = __uint_as_float(xi.x << 16) + acc[ai][bj][m][n][0], x1 = __uint_as_float(xi.x & 0xffff0000u) + acc[ai][bj][m][n][1];
                        const float x2 = __uint_as_float(xi.y << 16) + acc[ai][bj][m][n][2], x3 = __uint_as_float(xi.y & 0xffff0000u) + acc[ai][bj][m][n][3];
                        u32x2 w; w.x = cvt_pk_bf16(x0, x1); w.y = cvt_pk_bf16(x2, x3); *(u32x2*)(br + bj * HALF + n * 16) = w;
                        const float r0 = __uint_as_float(w.x << 16), r1 = __uint_as_float(w.x & 0xffff0000u), r2 = __uint_as_float(w.y << 16), r3 = __uint_as_float(w.y & 0xffff0000u);
                        ss += (r0 * r0 + r1 * r1) + (r2 * r2 + r3 * r3);
                    }
                ss += __shfl_xor(ss, 16); ss += __shfl_xor(ss, 32);
                if (fq == 0) ssq[(size_t)row * NSLOT + u.pn * 4 + wc] = ss;
            }
        }
    }
};
DEV float dpp_ror1(float v) { return __int_as_float(__builtin_amdgcn_update_dpp(0, __float_as_int(v), 0x121, 0xf, 0xf, false)); }
DEV float dpp_ror2(float v) { return __int_as_float(__builtin_amdgcn_update_dpp(0, __float_as_int(v), 0x122, 0xf, 0xf, false)); }
struct EpiAct {
    static constexpr bool PERM = true;
    bf16_t* ACT; const float* ssq; bf16_t* RAWG; bf16_t* RAWU; const float* cw; const float* st; float* outS;
    DEV void operator()(const f32x4 (&acc)[2][2][4][2], const Unit& u, int wr, int wc, int fr_in, int fq_in) const {
        int fr = fr_in, fq = fq_in; asm volatile("" : "+v"(fr), "+v"(fq));
        const int row0 = u.pm * BM + wr * 64 + fr, f0 = u.pn * HALF + wc * 32 + 8 * fq;
        const bool sample = u.pm >= MP / BM;
        float w0[8], w1[8], w2[8];
#pragma unroll
        for (int ai = 0; ai < 2; ++ai) {
            float rs[4];
#pragma unroll
            for (int hm = 0; hm < 2; ++hm) {
                f32x4 sv[2][4];
#pragma unroll
                for (int i = 0; i < 2; ++i)
#pragma unroll
                    for (int k = 0; k < 4; ++k) sv[i][k] = *(const f32x4*)(ssq + (size_t)(row0 + ai * HALF + (2 * hm + i) * 16) * NSLOT + 4 * k);
#pragma unroll
                for (int i = 0; i < 2; ++i) { const f32x4 s4 = (sv[i][0] + sv[i][1]) + (sv[i][2] + sv[i][3]); rs[2 * hm + i] = rsqrtf(((s4[0] + s4[1]) + (s4[2] + s4[3])) * (1.f / 1024.f) + 1e-6f); }
                __builtin_amdgcn_sched_barrier(0);
            }
            if (ai == 0) { const f32x4 a0 = *(const f32x4*)(cw + f0), a1 = *(const f32x4*)(cw + f0 + 4), b0 = *(const f32x4*)(cw + DFF + f0), b1 = *(const f32x4*)(cw + DFF + f0 + 4), c0 = *(const f32x4*)(cw + 2 * DFF + f0), c1 = *(const f32x4*)(cw + 2 * DFF + f0 + 4);
#pragma unroll
                for (int e = 0; e < 4; ++e) { w0[e] = a0[e]; w0[e + 4] = a1[e]; w1[e] = b0[e]; w1[e + 4] = b1[e]; w2[e] = c0[e]; w2[e + 4] = c1[e]; } }
            float p1[8], p2[8];
#pragma unroll
            for (int e = 0; e < 8; ++e) { p1[e] = 0.f; p2[e] = 0.f; }
#pragma unroll
            for (int m = 0; m < 4; ++m) {
                const int row = row0 + ai * HALF + m * 16;
                const int pos = fr & 3, sb = (row - MP) >> 2;
                u32x2 pkA[2], pkG[2], pkU[2];
#pragma unroll
                for (int hh = 0; hh < 2; ++hh) {
                    float gm[4], g1[4], g2[4], a[4], upv[4];
#pragma unroll
                    for (int e4 = 0; e4 < 4; ++e4) {
                        const int e = 4 * hh + e4;
                        gm[e4] = acc[ai][0][m][hh][e4] * rs[m];
                        const float r1c = dpp_ror1(gm[e4]), r2c = dpp_ror2(gm[e4]);
                        g1[e4] = fr >= 1 ? r1c : p1[e]; g2[e4] = fr >= 2 ? r2c : p2[e];
                        p1[e] = r1c; p2[e] = r2c;
                    }
                    if (sample) {
                        if (pos < 2) {
                            const f32x4 pp = *(const f32x4*)(st + (size_t)(sb * 2) * DFF + f0 + 4 * hh), qq = *(const f32x4*)(st + (size_t)(sb * 2 + 1) * DFF + f0 + 4 * hh);
#pragma unroll
                            for (int e4 = 0; e4 < 4; ++e4) { if (pos == 0) { g1[e4] = qq[e4]; g2[e4] = pp[e4]; } else g2[e4] = qq[e4]; }
                        } else *(f32x4*)(outS + (size_t)(sb * 2 + (pos - 2)) * DFF + f0 + 4 * hh) = (f32x4){gm[0], gm[1], gm[2], gm[3]};
                    }
#pragma unroll
                    for (int e4 = 0; e4 < 4; ++e4) { const int e = 4 * hh + e4; upv[e4] = acc[ai][1][m][hh][e4] * rs[m]; a[e4] = gelu_t(w0[e] * g2[e4] + w1[e] * g1[e4] + w2[e] * gm[e4]) * upv[e4]; }
                    pkA[hh].x = cvt_pk_bf16(a[0], a[1]); pkA[hh].y = cvt_pk_bf16(a[2], a[3]);
                    pkG[hh].x = cvt_pk_bf16(gm[0], gm[1]); pkG[hh].y = cvt_pk_bf16(gm[2], gm[3]);
                    pkU[hh].x = cvt_pk_bf16(upv[0], upv[1]); pkU[hh].y = cvt_pk_bf16(upv[2], upv[3]);
                    __builtin_amdgcn_sched_barrier(0);
                }
                const u32x4 wa = {pkA[0].x, pkA[0].y, pkA[1].x, pkA[1].y}, wg = {pkG[0].x, pkG[0].y, pkG[1].x, pkG[1].y}, wu = {pkU[0].x, pkU[0].y, pkU[1].x, pkU[1].y};
                const bool fix = !sample && m == 0 && fr < 2;
                if (fix) { *(u32x4*)(RAWG + (size_t)((row >> 6) * 4 + fr) * DFF + f0) = wg; *(u32x4*)(RAWU + (size_t)((row >> 6) * 2 + fr) * DFF + f0) = wu; }
                else *(u32x4*)(ACT + (size_t)row * DFF + f0) = wa;
                if (!sample && m == 3 && fr >= 14) *(u32x4*)(RAWG + (size_t)((row >> 6) * 4 + 2 + (fr - 14)) * DFF + f0) = wg;
                __builtin_amdgcn_sched_barrier(0);
            }
        }
    }
};
struct EpiPartial {
    static constexpr bool PERM = false;
    float* Z;
    DEV void operator()(const f32x4 (&acc)[2][2][4][2], const Unit& u, int wr, int wc, int fr, int fq) const {
        const int row0 = u.pm * BM - MP + wr * 64 + fr, col0 = u.pn * BM + wc * 32 + 4 * fq;
        float* zb = Z + (size_t)u.kh * MS * D;
#pragma unroll
        for (int ai = 0; ai < 2; ++ai)
#pragma unroll
            for (int m = 0; m < 4; ++m)
#pragma unroll
                for (int bj = 0; bj < 2; ++bj)
#pragma unroll
                    for (int n = 0; n < 2; ++n) *(f32x4*)(zb + (size_t)(row0 + ai * HALF + m * 16) * D + col0 + bj * HALF + n * 16) = acc[ai][bj][m][n];
    }
};
}

#define XB_TMO      128
#define XB_XCNT(j)  (256  + 64 * (j))
#define XB_XSUB(j)  (1280 + 64 * (j))
#define XB_XGEN(j)  (2304 + 64 * (j))
#define XB_TOP      3328
#define XB_TOPGEN   3392
#define XCD_BAR_WORDS 3456
#define XB_SPIN_CAP (1u << 20)
DEV unsigned xb_ld(unsigned* p)              { return __hip_atomic_load(p, __ATOMIC_RELAXED, __HIP_MEMORY_SCOPE_AGENT); }
DEV unsigned xb_add(unsigned* p, unsigned v) { return __hip_atomic_fetch_add(p, v, __ATOMIC_RELAXED, __HIP_MEMORY_SCOPE_AGENT); }
DEV unsigned xb_xcc_id() { return (unsigned)__builtin_amdgcn_s_getreg((3 << 11) | 20) & 0xFu; }
#define XB_SPIN(cond, bar) do { unsigned _sp = 0; while (cond) { __builtin_amdgcn_s_sleep(1); \
    if ((++_sp & 255u) == 0u) { if (xb_ld(&(bar)[XB_TMO])) break; if (_sp > XB_SPIN_CAP) { atomicAdd(&(bar)[XB_TMO], 1u); break; } } } } while (0)
struct XcdBarrier { unsigned* bar; unsigned x; volatile LAS unsigned* st; };
DEV XcdBarrier xcd_barrier_post(unsigned* bar, volatile LAS unsigned* st) {
    XcdBarrier b; b.bar = bar; b.x = xb_xcc_id(); b.st = st;
    if (threadIdx.x == 0) (void)xb_add(&bar[XB_XCNT(b.x)], 1u);
    return b;
}
DEV void xcd_barrier_complete(unsigned* bar, unsigned x, unsigned& nloc, unsigned& nx) {
    const unsigned G = gridDim.x * gridDim.y * gridDim.z;
    unsigned sum, cnt, mine, sp = 0u;
    for (;;) {
        sum = 0u; cnt = 0u; mine = 0u;
#pragma unroll
        for (unsigned j = 0; j < 16; ++j) { const unsigned c = xb_ld(&bar[XB_XCNT(j)]); sum += c; cnt += (c > 0u) ? 1u : 0u; mine = (j == x) ? c : mine; }
        if (sum == G) break;
        __builtin_amdgcn_s_sleep(1);
        if ((++sp & 255u) == 0u) { if (xb_ld(&bar[XB_TMO])) break; if (sp > XB_SPIN_CAP) { atomicAdd(&bar[XB_TMO], 1u); break; } }
    }
    nloc = mine > 0u ? mine : 1u; nx = cnt > 0u ? cnt : 1u;
}
DEV void xcd_barrier(const XcdBarrier& b) {
    asm volatile("s_waitcnt vmcnt(0)" ::: "memory");
    __syncthreads();
    if (threadIdx.x == 0) {
        unsigned* bar = b.bar;
        __builtin_amdgcn_s_waitcnt(0);
        unsigned nloc = b.st[0], nx = b.st[1];
        if (nloc == 0u) { xcd_barrier_complete(bar, b.x, nloc, nx); b.st[0] = nloc; b.st[1] = nx; }
        const unsigned old = xb_add(&bar[XB_XSUB(b.x)], 1u);
        const unsigned gen = old / nloc;
        if (old + 1u == (gen + 1u) * nloc) {
            __builtin_amdgcn_fence(__ATOMIC_RELEASE, "agent");
            asm volatile("s_waitcnt vmcnt(0)" ::: "memory");
            const unsigned og = xb_add(&bar[XB_TOP], 1u);
            const unsigned tg = og / nx;
            if (og + 1u == (tg + 1u) * nx) xb_add(&bar[XB_TOPGEN], 1u);
            else XB_SPIN(xb_ld(&bar[XB_TOPGEN]) == tg, bar);
            __builtin_amdgcn_fence(__ATOMIC_ACQUIRE, "agent");
            xb_add(&bar[XB_XGEN(b.x)], 1u);
            asm volatile("s_waitcnt vmcnt(0)" ::: "memory");
        } else {
            XB_SPIN(xb_ld(&bar[XB_XGEN(b.x)]) == gen, bar);
            __builtin_amdgcn_fence(__ATOMIC_ACQUIRE, "agent");
            asm volatile("s_waitcnt vmcnt(0)" ::: "memory");
        }
    }
    __syncthreads();
}

struct Ctx {
    const Params* p;
    unsigned char* ws;
    float* SSQ; float* GB; float* XF; bf16_t* XB; bf16_t* PROJ; bf16_t* QKVN; bf16_t* OAB; bf16_t* MERGED; bf16_t* HB;
    bf16_t *WP, *QGP, *KDP, *UTP, *ATP; float *CSA, *CSH, *GL;
    int tid, lane, wave, G, bid;
};
DEV unsigned char* wbuf(const Ctx& c, int l) { return c.ws + WS_WB + (size_t)(l & 1) * WB_STRIDE; }
DEV Ctx mk(const Params& prm) {
    Ctx c; c.p = &prm;
    size_t zoff = 0; asm volatile("" : "+s"(zoff)); unsigned char* w = prm.ws + zoff; c.ws = w;
    c.SSQ = (float*)(w + WS_SSQ); c.GB = (float*)(w + WS_GB); c.XF = (float*)(w + WS_XF); c.XB = (bf16_t*)(w + WS_XB);
    c.PROJ = (bf16_t*)(w + WS_PROJ); c.QKVN = (bf16_t*)(w + WS_QKVN);
    c.WP = (bf16_t*)(w + WS_WP); c.QGP = (bf16_t*)(w + WS_QGP); c.KDP = (bf16_t*)(w + WS_KDP); c.UTP = (bf16_t*)(w + WS_UTP); c.ATP = (bf16_t*)(w + WS_ATP);
    c.CSA = (float*)(w + WS_CSA); c.CSH = (float*)(w + WS_CSH); c.GL = (float*)(w + WS_GL);
    c.OAB = (bf16_t*)(w + WS_OAB); c.MERGED = (bf16_t*)(w + WS_MERGED); c.HB = (bf16_t*)(w + WS_HB);
    int tid = threadIdx.x; asm volatile("" : "+v"(tid));
    c.tid = tid; c.lane = tid & 63; c.wave = __builtin_amdgcn_readfirstlane(tid >> 6); c.G = gridDim.x; c.bid = blockIdx.x;
    return c;
}

DEV void tr_item(const float* W, int Nsrc, const float* kscale, bf16_t* WT, int ldk, int k0, int n0, int mode, LAS float* scr, int lane) {
    const int n = n0 + (lane & 31);
    int src = n;
    if (mode == 1) src = (n < 2048) ? n : (n < 5120 ? n + 8 : (n < 5128 ? n - 5120 + 2048 : -1));
    if (mode == 2) src = ((n >> 7) & 1) * DFF + (n >> 8) * 128 + (n & 127);
#pragma unroll 8
    for (int i = 0; i < 32; ++i) { const int kk = 2 * i + (lane >> 5); float v = 0.f;
        if (src >= 0) v = W[(size_t)(k0 + kk) * Nsrc + src];
        if (kscale) v *= kscale[k0 + kk];
        scr[kk * 33 + (lane & 31)] = v; }
    asm volatile("s_waitcnt lgkmcnt(0)" ::: "memory");
    const int cch = lane & 7;
#pragma unroll
    for (int j = 0; j < 4; ++j) { const int nn = (lane >> 3) + 8 * j; const LAS float* s = scr + (8 * cch) * 33 + nn;
        u32x4 o; o.x = pk2(s[0 * 33], s[1 * 33]); o.y = pk2(s[2 * 33], s[3 * 33]); o.z = pk2(s[4 * 33], s[5 * 33]); o.w = pk2(s[6 * 33], s[7 * 33]);
        *(u32x4*)(WT + (size_t)(n0 + nn) * ldk + k0 + 8 * cch) = o; }
    asm volatile("s_waitcnt lgkmcnt(0)" ::: "memory");
}
DEV void convert_layer(const Ctx& c, int l, int w, int nw, LAS unsigned char* lds) {
    LAS float* scr = (LAS float*)(lds + c.wave * 16384);
    unsigned char* wb = wbuf(c, l);
    const Params& p = *c.p;
    constexpr int I_IN = 16 * (NPROJ / 32), I_AB = 8 * 32, I_O = 16 * 32, I_FF = 16 * (2 * DFF / 32), I_DN = (DFF / 64) * 32, I_L = 2 * 4;
    constexpr int TOT = I_IN + 2 * I_AB + I_O + I_FF + I_DN + 8 * I_L;
    for (int it = w; it < TOT; it += nw) {
        int r = it;
        if (r < I_IN) { const int nb = NPROJ / 32; tr_item(p.in[I_WIN] + (size_t)l * D * 5128, 5128, p.in[I_N1] + l * D, (bf16_t*)(wb + WO_WIN), D, 64 * (r / nb), 32 * (r % nb), 1, scr, c.lane); continue; } r -= I_IN;
        if (r < I_AB) { tr_item(p.in[I_WBA] + (size_t)l * 512 * D, D, nullptr, (bf16_t*)(wb + WO_WAB), D, 64 * (r / 32), 32 * (r % 32), 0, scr, c.lane); continue; } r -= I_AB;
        if (r < I_AB) { tr_item(p.in[I_WBB] + (size_t)l * 512 * D, D, nullptr, (bf16_t*)(wb + WO_WAB) + 512, D, 64 * (r / 32), 32 * (r % 32), 0, scr, c.lane); continue; } r -= I_AB;
        if (r < I_O) { tr_item(p.in[I_WO] + (size_t)l * D * D, D, nullptr, (bf16_t*)(wb + WO_WO), D, 64 * (r / 32), 32 * (r % 32), 0, scr, c.lane); continue; } r -= I_O;
        if (r < I_FF) { const int nb = 2 * DFF / 32; tr_item(p.in[I_WFF] + (size_t)l * D * 2 * DFF, 2 * DFF, p.in[I_N2] + l * D, (bf16_t*)(wb + WO_WFF), D, 64 * (r / nb), 32 * (r % nb), 2, scr, c.lane); continue; } r -= I_FF;
        if (r < I_DN) { tr_item(p.in[I_WDN] + (size_t)l * DFF * D, D, nullptr, (bf16_t*)(wb + WO_WDN), DFF, 64 * (r / 32), 32 * (r % 32), 0, scr, c.lane); continue; } r -= I_DN;
        { const int mat = r / I_L, rr = r % I_L, blk = mat & 3, which = mat >> 2;
          const float* W = (which ? p.in[I_LWX] : p.in[I_LWA]) + (size_t)(l * 4 + blk) * 16384;
          bf16_t* WT = (bf16_t*)(wb + (which ? WO_LWX : WO_LWA)) + blk * 16384;
          tr_item(W, 128, nullptr, WT, 128, 64 * (rr / 4), 32 * (rr % 4), 0, scr, c.lane); }
    }
}

DEV void x_prologue(const Ctx& c) {
    const int gw = c.bid * 8 + c.wave, NGW = c.G * 8;
    for (int row = gw; row < M; row += NGW) {
        const float* src = row < MP ? c.p->in[I_XP] + (size_t)row * D : c.p->in[I_XS] + (size_t)(row - MP) * D;
        float ss = 0.f;
#pragma unroll
        for (int j = 0; j < 4; ++j) { const f32x4 v = *(const f32x4*)(src + j * 256 + c.lane * 4);
            u32x2 w; w.x = pk2(v[0], v[1]); w.y = pk2(v[2], v[3]); *(u32x2*)(c.XB + (size_t)row * D + j * 256 + c.lane * 4) = w;
            const float r0 = __uint_as_float(w.x << 16), r1 = __uint_as_float(w.x & 0xffff0000u), r2 = __uint_as_float(w.y << 16), r3 = __uint_as_float(w.y & 0xffff0000u);
            ss += (r0 * r0 + r1 * r1) + (r2 * r2 + r3 * r3); }
        ss = wave_sum(ss);
        if (c.lane < NSLOT) c.SSQ[(size_t)row * NSLOT + c.lane] = (c.lane == 0) ? ss : 0.f;
    }
}

DEV void dn_prep_rows(const Ctx& c, int l) {
    const Params& p = *c.p;
    const int gw = c.bid * 8 + c.wave, NGW = c.G * 8, lane = c.lane;
    const float* cw = p.in[I_DCW] + (size_t)l * 4 * 1536;
    for (int row = MP + gw; row < M; row += NGW) {
        const int sb = (row - MP) >> 2, pos = (row - MP) & 3; const float* hist = p.in[I_SDC] + (size_t)(l * SBATCH + sb) * 3 * 1536;
#pragma unroll
        for (int ch = 0; ch < 3; ++ch) {
            const int col = ch * 512 + lane * 8;
            float a[8];
#pragma unroll
            for (int e = 0; e < 8; ++e) a[e] = 0.f;
            float own[8];
#pragma unroll
            for (int j = 0; j < 4; ++j) {
                float v[8];
                const int sp = pos - 3 + j;
                if (sp >= 0) unpack8(*(const u32x4*)(c.PROJ + (size_t)(row - 3 + j) * NPROJ + C_QKV + col), v);
                else { const f32x4 h0 = *(const f32x4*)(hist + (size_t)(pos + j) * 1536 + col), h1 = *(const f32x4*)(hist + (size_t)(pos + j) * 1536 + col + 4);
                    v[0] = h0[0]; v[1] = h0[1]; v[2] = h0[2]; v[3] = h0[3]; v[4] = h1[0]; v[5] = h1[1]; v[6] = h1[2]; v[7] = h1[3]; }
                const f32x4 w0 = *(const f32x4*)(cw + j * 1536 + col), w1 = *(const f32x4*)(cw + j * 1536 + col + 4);
#pragma unroll
                for (int e = 0; e < 4; ++e) { a[e] += v[e] * w0[e]; a[e + 4] += v[e + 4] * w1[e]; }
                if (j == 3) {
#pragma unroll
                    for (int e = 0; e < 8; ++e) own[e] = v[e]; }
            }
            float ss = 0.f;
#pragma unroll
            for (int e = 0; e < 8; ++e) { a[e] = siluf_(a[e]); ss += a[e] * a[e]; }
            if (ch < 2) {
                ss += __shfl_xor(ss, 1); ss += __shfl_xor(ss, 2); ss += __shfl_xor(ss, 4); ss += __shfl_xor(ss, 8);
                const float sc = rsqrtf(ss + 1e-6f) * (ch == 0 ? 0.08838834764831845f : 1.f);
#pragma unroll
                for (int e = 0; e < 8; ++e) a[e] *= sc;
            }
            *(u32x4*)(c.QKVN + (size_t)(row - MP) * 1536 + col) = pack8(a);
            if (pos >= 1) { float* dst = p.out + O_SDC + ((size_t)(l * SBATCH + sb) * 3 + (pos - 1)) * 1536 + col;
                *(f32x4*)dst = (f32x4){own[0], own[1], own[2], own[3]}; *(f32x4*)(dst + 4) = (f32x4){own[4], own[5], own[6], own[7]}; }
        }
        if (lane < 4) {
            const float ain = bf2f(c.PROJ[(size_t)row * NPROJ + C_AIN + lane]), bin = bf2f(c.PROJ[(size_t)row * NPROJ + C_BIN + lane]);
            const float g = -__expf(p.in[I_ALOG][l * 4 + lane]) * softplus_(ain + p.in[I_DTB][l * 4 + lane]);
            c.GB[(size_t)(row - MP) * 8 + lane] = g; c.GB[(size_t)(row - MP) * 8 + 4 + lane] = sigm(bin);
        }
    }
}

DEV int slot_of(int idx) { return (idx & ~31) | (((idx >> 2) & 3) << 3) | (((idx >> 4) & 1) << 2) | (idx & 3); }
template <int I> struct SolveRow {
    template <int NC> static DEV void run(float (&X)[64], const LAS float* Mv, const f32x4 (&cur)[NC]) {
        constexpr int NV = (I + 3) / 4;
        constexpr int NLATE = NV > 8 ? NV - 8 : 0;
        constexpr int NN = ((I + 1 + 3) / 4) > 8 ? 8 : ((I + 1 + 3) / 4);
        f32x4 late[NLATE > 0 ? NLATE : 1];
#pragma unroll
        for (int k = 0; k < NLATE; ++k) late[k] = *(const LAS f32x4*)(Mv + I * 68 + 4 * (8 + k));
        f32x4 nxt[NN];
        if constexpr (I + 1 < 64) {
#pragma unroll
            for (int k = 0; k < NN; ++k) nxt[k] = *(const LAS f32x4*)(Mv + (I + 1) * 68 + 4 * k);
        }
        __builtin_amdgcn_sched_barrier(0);
        float a0 = X[I], a1 = 0.f, a2 = 0.f, a3 = 0.f;
#pragma unroll
        for (int k = 0; k < NV; ++k) {
            const f32x4 mv = k < 8 ? cur[k < NC ? k : 0] : late[k >= 8 ? k - 8 : 0];
            a0 -= mv[0] * X[4 * k];
            if (4 * k + 1 < I) a1 -= mv[1] * X[4 * k + 1];
            if (4 * k + 2 < I) a2 -= mv[2] * X[4 * k + 2];
            if (4 * k + 3 < I) a3 -= mv[3] * X[4 * k + 3];
        }
        X[I] = (a0 + a1) + (a2 + a3);
        __builtin_amdgcn_sched_barrier(0);
        if constexpr (I + 1 < 64) SolveRow<I + 1>::run(X, Mv, nxt);
    }
};
DEV void dn_chunk_prep(const Ctx& c, int l, int item, LAS unsigned char* lds) {
    const Params& p = *c.p;
    const int b = item >> 7, n = (item >> 2) & 31, h = item & 3, row0 = b * SEQ + n * 64, tid = c.tid, lane = c.lane, wave = c.wave;
    LAS float* Mm = (LAS float*)lds;
    LAS float* gcs = (LAS float*)(lds + 17408);
    LAS bf16_t* qn = (LAS bf16_t*)(lds + 18432);
    LAS bf16_t* kn = qn + 64 * 136;
    LAS bf16_t* vv = kn + 64 * 136;
    LAS float* bet = gcs + 64; LAS float* egs = gcs + 128; LAS float* bke = gcs + 192;
    bf16_t* QGP = c.QGP + (size_t)item * 8192; bf16_t* WP = c.WP + (size_t)item * 8192; bf16_t* KDP = c.KDP + (size_t)item * 8192;
    bf16_t* UTP = c.UTP + (size_t)item * 8192; bf16_t* ATP = c.ATP + (size_t)item * 4096;
    LAS float* cwl = (LAS float*)(lds + 70656);
    if (tid < 384) {
        const int ch = tid >> 7, cc = tid & 127;
#pragma unroll
        for (int j = 0; j < 4; ++j) cwl[j * 384 + tid] = p.in[I_DCW][(size_t)(l * 4 + j) * 1536 + ch * 512 + h * 128 + cc];
    }
    if (tid < 64) {
        const int row = row0 + tid;
        const float ain = bf2f(c.PROJ[(size_t)row * NPROJ + C_AIN + h]), bin = bf2f(c.PROJ[(size_t)row * NPROJ + C_BIN + h]);
        float g = -__expf(p.in[I_ALOG][l * 4 + h]) * softplus_(ain + p.in[I_DTB][l * 4 + h]);
        const float be = sigm(bin);
#pragma unroll
        for (int o = 1; o < 64; o <<= 1) { const float t = __shfl_up(g, o); if (lane >= o) g += t; }
        const float e = __expf(g);
        gcs[tid] = g; bet[tid] = be; egs[tid] = e; bke[tid] = be * e;
    }
    __syncthreads();
    {
        const int r = tid >> 3, sub = tid & 7, row = row0 + r;
        const float eg_r = egs[r];
#pragma unroll 1
        for (int ch = 0; ch < 3; ++ch) {
            float a[2][8]; float ss = 0.f;
#pragma unroll
            for (int gi = 0; gi < 2; ++gi) {
                const int col8 = (sub + 8 * gi) * 8, gcol = ch * 512 + h * 128 + col8;
                const LAS float* cw = cwl + ch * 128 + col8;
#pragma unroll
                for (int e = 0; e < 8; ++e) a[gi][e] = 0.f;
#pragma unroll
                for (int j = 0; j < 4; ++j) {
                    float v[8];
                    if (n > 0 || r - 3 + j >= 0) unpack8(*(const u32x4*)(c.PROJ + (size_t)(row - 3 + j) * NPROJ + C_QKV + gcol), v);
                    else {
#pragma unroll
                        for (int e = 0; e < 8; ++e) v[e] = 0.f; }
                    const f32x4 w0 = *(const LAS f32x4*)(cw + j * 384), w1 = *(const LAS f32x4*)(cw + j * 384 + 4);
#pragma unroll
                    for (int e = 0; e < 4; ++e) { a[gi][e] += v[e] * w0[e]; a[gi][e + 4] += v[e + 4] * w1[e]; }
                    if (j == 3 && n == 31 && r >= 61) { float* dst = p.out + O_PDC + ((size_t)(l * NBATCH + b) * 3 + (r - 61)) * 1536 + gcol;
                        *(f32x4*)dst = (f32x4){v[0], v[1], v[2], v[3]}; *(f32x4*)(dst + 4) = (f32x4){v[4], v[5], v[6], v[7]}; }
                }
#pragma unroll
                for (int e = 0; e < 8; ++e) { a[gi][e] = siluf_(a[gi][e]); ss += a[gi][e] * a[gi][e]; }
            }
            if (ch < 2) {
                ss += __shfl_xor(ss, 1); ss += __shfl_xor(ss, 2); ss += __shfl_xor(ss, 4);
                const float sc = rsqrtf(ss + 1e-6f) * (ch == 0 ? 0.08838834764831845f : 1.f);
#pragma unroll
                for (int gi = 0; gi < 2; ++gi)
#pragma unroll
                    for (int e = 0; e < 8; ++e) a[gi][e] *= sc;
            }
            LAS bf16_t* tile = qn + ch * (64 * 136);
#pragma unroll
            for (int gi = 0; gi < 2; ++gi) {
                const int col8 = (sub + 8 * gi) * 8;
                *(LAS u32x4*)(tile + r * 136 + col8) = pack8(a[gi]);
                if (ch == 0) {
                    const int grp = sub + 8 * gi, s = grp >> 2, aa = (grp >> 1) & 1, hh = grp & 1;
                    u32x2 w0, w1; w0.x = pk2(a[gi][0] * eg_r, a[gi][1] * eg_r); w0.y = pk2(a[gi][2] * eg_r, a[gi][3] * eg_r);
                    w1.x = pk2(a[gi][4] * eg_r, a[gi][5] * eg_r); w1.y = pk2(a[gi][6] * eg_r, a[gi][7] * eg_r);
                    *(u32x2*)(QGP + r * 128 + 32 * s + 16 * hh + 4 * aa) = w0; *(u32x2*)(QGP + r * 128 + 32 * s + 16 * hh + 8 + 4 * aa) = w1;
                }
            }
        }
    }
    __syncthreads();
    {
        const int mi = wave & 3, which = wave >> 2, fr = lane & 15, q = lane >> 4;
        const LAS bf16_t* At = which ? qn : kn;
        bf16x8 af[4];
#pragma unroll
        for (int s = 0; s < 4; ++s) af[s] = *(const LAS bf16x8*)(At + (16 * mi + fr) * 136 + 32 * s + 8 * q);
#pragma unroll
        for (int nj = 0; nj < 4; ++nj) {
            f32x4 acc = {0.f, 0.f, 0.f, 0.f};
            if (nj <= mi) {
#pragma unroll
                for (int s = 0; s < 4; ++s) { const bf16x8 bfr = *(const LAS bf16x8*)(kn + (16 * nj + fr) * 136 + 32 * s + 8 * q);
                    acc = __builtin_amdgcn_mfma_f32_16x16x32_bf16(af[s], bfr, acc, 0, 0, 0); }
            }
            const int j = 16 * nj + fr; const float gj = gcs[j];
#pragma unroll
            for (int r = 0; r < 4; ++r) {
                const int i = 16 * mi + 4 * q + r;
                if (which == 0) { if (nj <= mi) Mm[i * 68 + j] = (i > j) ? bet[i] * acc[r] * __expf(gcs[i] - gj) : 0.f; }
                else { const float v = (i >= j) ? acc[r] * __expf(gcs[i] - gj) : 0.f; ATP[i * 64 + slot_of(j)] = (bf16_t)f2bf(v); }
            }
        }
    }
    __syncthreads();
    if (wave < 4) {
        const int isK = wave >> 1, col = 64 * (wave & 1) + lane;
        const LAS bf16_t* src = isK ? kn : vv; const LAS float* mul = isK ? bke : bet;
        float X[64];
#pragma unroll
        for (int i = 0; i < 64; ++i) X[i] = bf2f(src[i * 136 + col]);
        {   int zl0 = 0; asm volatile("" : "+v"(zl0)); const LAS float* mulv = mul + zl0;
#pragma unroll
            for (int i4 = 0; i4 < 16; ++i4) { const f32x4 mm = *(const LAS f32x4*)(mulv + 4 * i4); X[4 * i4] *= mm[0]; X[4 * i4 + 1] *= mm[1]; X[4 * i4 + 2] *= mm[2]; X[4 * i4 + 3] *= mm[3]; } }
        int zl = 0; asm volatile("" : "+v"(zl));
        const LAS float* Mv = Mm + zl;
        { f32x4 cur1[1]; cur1[0] = *(const LAS f32x4*)(Mv + 68); SolveRow<1>::run(X, Mv, cur1); }
        if (!isK) {
#pragma unroll
            for (int t8 = 0; t8 < 8; ++t8) { u32x4 w; w.x = pk2(X[8 * t8], X[8 * t8 + 1]); w.y = pk2(X[8 * t8 + 2], X[8 * t8 + 3]); w.z = pk2(X[8 * t8 + 4], X[8 * t8 + 5]); w.w = pk2(X[8 * t8 + 6], X[8 * t8 + 7]);
                *(u32x4*)(UTP + col * 64 + 8 * t8) = w; }
        } else {
            const int sl = slot_of(col);
#pragma unroll
            for (int t = 0; t < 64; ++t) WP[t * 128 + sl] = (bf16_t)f2bf(X[t]);
        }
    } else {
        const int tt = tid - 256, dk = tt >> 1, s = tt & 1;
        const float gl = gcs[63];
#pragma unroll
        for (int qq = 0; qq < 4; ++qq) {
            float v[8];
#pragma unroll
            for (int j = 0; j < 8; ++j) { const int t = 32 * s + 16 * (j >> 2) + 4 * qq + (j & 3); v[j] = bf2f(kn[t * 136 + dk]) * __expf(gl - gcs[t]); }
            *(u32x4*)(KDP + dk * 64 + 32 * s + 8 * qq) = pack8(v);
        }
        if (tt == 0) c.GL[item] = __expf(gl);
    }
    __syncthreads();
}

DEV void dn_chunk_scan(const Ctx& c, int l, int b, int h, LAS unsigned char* lds) {
    const Params& p = *c.p;
    const int tid = c.tid, lane = c.lane, wave = c.wave, fr = lane & 15, q = lane >> 4, dvc = 16 * wave + fr;
    LAS unsigned char* wl = lds;
    LAS unsigned char* ql = lds + 17408;
    LAS unsigned char* kl = lds + 34816;
    LAS unsigned char* al = lds + 53248;
    LAS float* obuf = (LAS float*)(lds + 62464);
    unsigned soff[7], doff[7];
#pragma unroll
    for (int k = 0; k < 7; ++k) {
        const int pc = tid + 512 * k;
        if (k < 2) { soff[k] = pc * 16; doff[k] = (pc >> 4) * 272 + (pc & 15) * 16; }
        else if (k < 4) { const int pp = pc - 1024; soff[k] = pp * 16; doff[k] = 17408 + (pp >> 4) * 272 + (pp & 15) * 16; }
        else if (k < 6) { const int pp = pc - 2048; soff[k] = pp * 16; doff[k] = 34816 + (pp >> 3) * 144 + (pp & 7) * 16; }
        else { const int pp = pc - 3072; soff[k] = pp * 16; doff[k] = 53248 + (pp >> 3) * 144 + (pp & 7) * 16; }
    }
    const int it0 = (b * 32) * 4 + h;
    u32x4 pf[7];
#define DN_LOAD(itm) do { const size_t io = (size_t)(itm) * 16384; \
        pf[0] = *(const u32x4*)((const char*)c.WP + io + soff[0]); pf[1] = *(const u32x4*)((const char*)c.WP + io + soff[1]); \
        pf[2] = *(const u32x4*)((const char*)c.QGP + io + soff[2]); pf[3] = *(const u32x4*)((const char*)c.QGP + io + soff[3]); \
        pf[4] = *(const u32x4*)((const char*)c.KDP + io + soff[4]); pf[5] = *(const u32x4*)((const char*)c.KDP + io + soff[5]); \
        pf[6] = *(const u32x4*)((const char*)c.ATP + (size_t)(itm) * 8192 + soff[6]); } while (0)
#define DN_STORE() do { _Pragma("unroll") for (int k = 0; k < 7; ++k) *(LAS u32x4*)(lds + doff[k]) = pf[k]; } while (0)
    DN_LOAD(it0); DN_STORE();
    __syncthreads();
    f32x4 S[8];
#pragma unroll
    for (int i = 0; i < 8; ++i) S[i] = (f32x4){0.f, 0.f, 0.f, 0.f};
    const int ft = tid >> 3, fc = (tid & 7) * 16;
    f32x4 nw[4];
#pragma unroll
    for (int k = 0; k < 4; ++k) nw[k] = *(const f32x4*)(p.in[I_DNW] + l * 128 + fc + 4 * k);
    u32x2 uu[4], un[4]; float gl = c.GL[it0], gln = 0.f;
#pragma unroll
    for (int m = 0; m < 4; ++m) { uu[m] = *(const u32x2*)(c.UTP + (size_t)it0 * 8192 + dvc * 64 + 16 * m + 4 * q); un[m] = uu[m]; }
    for (int n = 0; n < 32; ++n) {
        const int itm = it0 + n * 4;
        if (n + 1 < 32) {
#pragma unroll
            for (int m = 0; m < 4; ++m) un[m] = *(const u32x2*)(c.UTP + (size_t)(itm + 4) * 8192 + dvc * 64 + 16 * m + 4 * q);
            gln = c.GL[itm + 4];
        }
        const u32x4 zr0 = *(const u32x4*)(c.PROJ + (size_t)(b * SEQ + n * 64 + ft) * NPROJ + C_Z + h * 128 + fc), zr1 = *(const u32x4*)(c.PROJ + (size_t)(b * SEQ + n * 64 + ft) * NPROJ + C_Z + h * 128 + fc + 8);
        if (n + 1 < 32) DN_LOAD(itm + 4);
        bf16x8 Sb[4];
#pragma unroll
        for (int s = 0; s < 4; ++s) { union { u32x4 u; bf16x8 v; } t; t.u.x = pk2(S[2 * s][0], S[2 * s][1]); t.u.y = pk2(S[2 * s][2], S[2 * s][3]); t.u.z = pk2(S[2 * s + 1][0], S[2 * s + 1][1]); t.u.w = pk2(S[2 * s + 1][2], S[2 * s + 1][3]); Sb[s] = t.v; }
        f32x4 vn[4]; bf16x8 vb[2]; bf16x8 fa[6], fb[6];
        fa[0] = *(const LAS bf16x8*)(wl + (16 * 0 + fr) * 272 + 64 * 0 + 16 * q); fa[1] = *(const LAS bf16x8*)(wl + (16 * 0 + fr) * 272 + 64 * 1 + 16 * q); fa[2] = *(const LAS bf16x8*)(wl + (16 * 0 + fr) * 272 + 64 * 2 + 16 * q); fa[3] = *(const LAS bf16x8*)(wl + (16 * 0 + fr) * 272 + 64 * 3 + 16 * q);
        fb[0] = *(const LAS bf16x8*)(wl + (16 * 1 + fr) * 272 + 64 * 0 + 16 * q); fb[1] = *(const LAS bf16x8*)(wl + (16 * 1 + fr) * 272 + 64 * 1 + 16 * q); fb[2] = *(const LAS bf16x8*)(wl + (16 * 1 + fr) * 272 + 64 * 2 + 16 * q); fb[3] = *(const LAS bf16x8*)(wl + (16 * 1 + fr) * 272 + 64 * 3 + 16 * q);
        __builtin_amdgcn_sched_barrier(0);
            { f32x4 P = {0.f, 0.f, 0.f, 0.f};
              P = __builtin_amdgcn_mfma_f32_16x16x32_bf16(fa[0], Sb[0], P, 0, 0, 0);
              P = __builtin_amdgcn_mfma_f32_16x16x32_bf16(fa[1], Sb[1], P, 0, 0, 0);
              P = __builtin_amdgcn_mfma_f32_16x16x32_bf16(fa[2], Sb[2], P, 0, 0, 0);
              P = __builtin_amdgcn_mfma_f32_16x16x32_bf16(fa[3], Sb[3], P, 0, 0, 0);
              vn[0][0] = __uint_as_float(uu[0].x << 16) - P[0]; vn[0][1] = __uint_as_float(uu[0].x & 0xffff0000u) - P[1]; vn[0][2] = __uint_as_float(uu[0].y << 16) - P[2]; vn[0][3] = __uint_as_float(uu[0].y & 0xffff0000u) - P[3]; }
        __builtin_amdgcn_sched_barrier(0);
        fa[0] = *(const LAS bf16x8*)(wl + (16 * 2 + fr) * 272 + 64 * 0 + 16 * q); fa[1] = *(const LAS bf16x8*)(wl + (16 * 2 + fr) * 272 + 64 * 1 + 16 * q); fa[2] = *(const LAS bf16x8*)(wl + (16 * 2 + fr) * 272 + 64 * 2 + 16 * q); fa[3] = *(const LAS bf16x8*)(wl + (16 * 2 + fr) * 272 + 64 * 3 + 16 * q);
        __builtin_amdgcn_sched_barrier(0);
            { f32x4 P = {0.f, 0.f, 0.f, 0.f};
              P = __builtin_amdgcn_mfma_f32_16x16x32_bf16(fb[0], Sb[0], P, 0, 0, 0);
              P = __builtin_amdgcn_mfma_f32_16x16x32_bf16(fb[1], Sb[1], P, 0, 0, 0);
              P = __builtin_amdgcn_mfma_f32_16x16x32_bf16(fb[2], Sb[2], P, 0, 0, 0);
              P = __builtin_amdgcn_mfma_f32_16x16x32_bf16(fb[3], Sb[3], P, 0, 0, 0);
              vn[1][0] = __uint_as_float(uu[1].x << 16) - P[0]; vn[1][1] = __uint_as_float(uu[1].x & 0xffff0000u) - P[1]; vn[1][2] = __uint_as_float(uu[1].y << 16) - P[2]; vn[1][3] = __uint_as_float(uu[1].y & 0xffff0000u) - P[3]; }
        __builtin_amdgcn_sched_barrier(0);
        fb[0] = *(const LAS bf16x8*)(wl + (16 * 3 + fr) * 272 + 64 * 0 + 16 * q); fb[1] = *(const LAS bf16x8*)(wl + (16 * 3 + fr) * 272 + 64 * 1 + 16 * q); fb[2] = *(const LAS bf16x8*)(wl + (16 * 3 + fr) * 272 + 64 * 2 + 16 * q); fb[3] = *(const LAS bf16x8*)(wl + (16 * 3 + fr) * 272 + 64 * 3 + 16 * q);
        __builtin_amdgcn_sched_barrier(0);
            { f32x4 P = {0.f, 0.f, 0.f, 0.f};
              P = __builtin_amdgcn_mfma_f32_16x16x32_bf16(fa[0], Sb[0], P, 0, 0, 0);
              P = __builtin_amdgcn_mfma_f32_16x16x32_bf16(fa[1], Sb[1], P, 0, 0, 0);
              P = __builtin_amdgcn_mfma_f32_16x16x32_bf16(fa[2], Sb[2], P, 0, 0, 0);
              P = __builtin_amdgcn_mfma_f32_16x16x32_bf16(fa[3], Sb[3], P, 0, 0, 0);
              vn[2][0] = __uint_as_float(uu[2].x << 16) - P[0]; vn[2][1] = __uint_as_float(uu[2].x & 0xffff0000u) - P[1]; vn[2][2] = __uint_as_float(uu[2].y << 16) - P[2]; vn[2][3] = __uint_as_float(uu[2].y & 0xffff0000u) - P[3]; }
        __builtin_amdgcn_sched_barrier(0);
        fa[0] = *(const LAS bf16x8*)(ql + (16 * 0 + fr) * 272 + 64 * 0 + 16 * q); fa[1] = *(const LAS bf16x8*)(ql + (16 * 0 + fr) * 272 + 64 * 1 + 16 * q); fa[2] = *(const LAS bf16x8*)(ql + (16 * 0 + fr) * 272 + 64 * 2 + 16 * q); fa[3] = *(const LAS bf16x8*)(ql + (16 * 0 + fr) * 272 + 64 * 3 + 16 * q); fa[4] = *(const LAS bf16x8*)(al + (16 * 0 + fr) * 144 + 64 * 0 + 16 * q); fa[5] = *(const LAS bf16x8*)(al + (16 * 0 + fr) * 144 + 64 * 1 + 16 * q);
        __builtin_amdgcn_sched_barrier(0);
            { f32x4 P = {0.f, 0.f, 0.f, 0.f};
              P = __builtin_amdgcn_mfma_f32_16x16x32_bf16(fb[0], Sb[0], P, 0, 0, 0);
              P = __builtin_amdgcn_mfma_f32_16x16x32_bf16(fb[1], Sb[1], P, 0, 0, 0);
              P = __builtin_amdgcn_mfma_f32_16x16x32_bf16(fb[2], Sb[2], P, 0, 0, 0);
              P = __builtin_amdgcn_mfma_f32_16x16x32_bf16(fb[3], Sb[3], P, 0, 0, 0);
              vn[3][0] = __uint_as_float(uu[3].x << 16) - P[0]; vn[3][1] = __uint_as_float(uu[3].x & 0xffff0000u) - P[1]; vn[3][2] = __uint_as_float(uu[3].y << 16) - P[2]; vn[3][3] = __uint_as_float(uu[3].y & 0xffff0000u) - P[3]; }
            for (int s = 0; s < 2; ++s) { union { u32x4 u; bf16x8 v; } t; t.u.x = pk2(vn[2 * s][0], vn[2 * s][1]); t.u.y = pk2(vn[2 * s][2], vn[2 * s][3]); t.u.z = pk2(vn[2 * s + 1][0], vn[2 * s + 1][1]); t.u.w = pk2(vn[2 * s + 1][2], vn[2 * s + 1][3]); vb[s] = t.v; }
        __builtin_amdgcn_sched_barrier(0);
        fb[0] = *(const LAS bf16x8*)(ql + (16 * 1 + fr) * 272 + 64 * 0 + 16 * q); fb[1] = *(const LAS bf16x8*)(ql + (16 * 1 + fr) * 272 + 64 * 1 + 16 * q); fb[2] = *(const LAS bf16x8*)(ql + (16 * 1 + fr) * 272 + 64 * 2 + 16 * q); fb[3] = *(const LAS bf16x8*)(ql + (16 * 1 + fr) * 272 + 64 * 3 + 16 * q); fb[4] = *(const LAS bf16x8*)(al + (16 * 1 + fr) * 144 + 64 * 0 + 16 * q); fb[5] = *(const LAS bf16x8*)(al + (16 * 1 + fr) * 144 + 64 * 1 + 16 * q);
        __builtin_amdgcn_sched_barrier(0);
            { f32x4 O = {0.f, 0.f, 0.f, 0.f};
              O = __builtin_amdgcn_mfma_f32_16x16x32_bf16(fa[0], Sb[0], O, 0, 0, 0);
              O = __builtin_amdgcn_mfma_f32_16x16x32_bf16(fa[1], Sb[1], O, 0, 0, 0);
              O = __builtin_amdgcn_mfma_f32_16x16x32_bf16(fa[2], Sb[2], O, 0, 0, 0);
              O = __builtin_amdgcn_mfma_f32_16x16x32_bf16(fa[3], Sb[3], O, 0, 0, 0);
              O = __builtin_amdgcn_mfma_f32_16x16x32_bf16(fa[4], vb[0], O, 0, 0, 0);
              O = __builtin_amdgcn_mfma_f32_16x16x32_bf16(fa[5], vb[1], O, 0, 0, 0);
              for (int r = 0; r < 4; ++r) obuf[(16 * 0 + 4 * q + r) * 132 + dvc] = O[r]; }
        __builtin_amdgcn_sched_barrier(0);
        fa[0] = *(const LAS bf16x8*)(ql + (16 * 2 + fr) * 272 + 64 * 0 + 16 * q); fa[1] = *(const LAS bf16x8*)(ql + (16 * 2 + fr) * 272 + 64 * 1 + 16 * q); fa[2] = *(const LAS bf16x8*)(ql + (16 * 2 + fr) * 272 + 64 * 2 + 16 * q); fa[3] = *(const LAS bf16x8*)(ql + (16 * 2 + fr) * 272 + 64 * 3 + 16 * q); fa[4] = *(const LAS bf16x8*)(al + (16 * 2 + fr) * 144 + 64 * 0 + 16 * q); fa[5] = *(const LAS bf16x8*)(al + (16 * 2 + fr) * 144 + 64 * 1 + 16 * q);
        __builtin_amdgcn_sched_barrier(0);
            { f32x4 O = {0.f, 0.f, 0.f, 0.f};
              O = __builtin_amdgcn_mfma_f32_16x16x32_bf16(fb[0], Sb[0], O, 0, 0, 0);
              O = __builtin_amdgcn_mfma_f32_16x16x32_bf16(fb[1], Sb[1], O, 0, 0, 0);
              O = __builtin_amdgcn_mfma_f32_16x16x32_bf16(fb[2], Sb[2], O, 0, 0, 0);
              O = __builtin_amdgcn_mfma_f32_16x16x32_bf16(fb[3], Sb[3], O, 0, 0, 0);
              O = __builtin_amdgcn_mfma_f32_16x16x32_bf16(fb[4], vb[0], O, 0, 0, 0);
              O = __builtin_amdgcn_mfma_f32_16x16x32_bf16(fb[5], vb[1], O, 0, 0, 0);
              for (int r = 0; r < 4; ++r) obuf[(16 * 1 + 4 * q + r) * 132 + dvc] = O[r]; }
        __builtin_amdgcn_sched_barrier(0);
        fb[0] = *(const LAS bf16x8*)(ql + (16 * 3 + fr) * 272 + 64 * 0 + 16 * q); fb[1] = *(const LAS bf16x8*)(ql + (16 * 3 + fr) * 272 + 64 * 1 + 16 * q); fb[2] = *(const LAS bf16x8*)(ql + (16 * 3 + fr) * 272 + 64 * 2 + 16 * q); fb[3] = *(const LAS bf16x8*)(ql + (16 * 3 + fr) * 272 + 64 * 3 + 16 * q); fb[4] = *(const LAS bf16x8*)(al + (16 * 3 + fr) * 144 + 64 * 0 + 16 * q); fb[5] = *(const LAS bf16x8*)(al + (16 * 3 + fr) * 144 + 64 * 1 + 16 * q);
        __builtin_amdgcn_sched_barrier(0);
            { f32x4 O = {0.f, 0.f, 0.f, 0.f};
              O = __builtin_amdgcn_mfma_f32_16x16x32_bf16(fa[0], Sb[0], O, 0, 0, 0);
              O = __builtin_amdgcn_mfma_f32_16x16x32_bf16(fa[1], Sb[1], O, 0, 0, 0);
              O = __builtin_amdgcn_mfma_f32_16x16x32_bf16(fa[2], Sb[2], O, 0, 0, 0);
              O = __builtin_amdgcn_mfma_f32_16x16x32_bf16(fa[3], Sb[3], O, 0, 0, 0);
              O = __builtin_amdgcn_mfma_f32_16x16x32_bf16(fa[4], vb[0], O, 0, 0, 0);
              O = __builtin_amdgcn_mfma_f32_16x16x32_bf16(fa[5], vb[1], O, 0, 0, 0);
              for (int r = 0; r < 4; ++r) obuf[(16 * 2 + 4 * q + r) * 132 + dvc] = O[r]; }
        __builtin_amdgcn_sched_barrier(0);
        fa[0] = *(const LAS bf16x8*)(kl + (16 * 0 + fr) * 144 + 64 * 0 + 16 * q); fa[1] = *(const LAS bf16x8*)(kl + (16 * 0 + fr) * 144 + 64 * 1 + 16 * q); fa[2] = *(const LAS bf16x8*)(kl + (16 * 1 + fr) * 144 + 64 * 0 + 16 * q); fa[3] = *(const LAS bf16x8*)(kl + (16 * 1 + fr) * 144 + 64 * 1 + 16 * q);
        __builtin_amdgcn_sched_barrier(0);
            { f32x4 O = {0.f, 0.f, 0.f, 0.f};
              O = __builtin_amdgcn_mfma_f32_16x16x32_bf16(fb[0], Sb[0], O, 0, 0, 0);
              O = __builtin_amdgcn_mfma_f32_16x16x32_bf16(fb[1], Sb[1], O, 0, 0, 0);
              O = __builtin_amdgcn_mfma_f32_16x16x32_bf16(fb[2], Sb[2], O, 0, 0, 0);
              O = __builtin_amdgcn_mfma_f32_16x16x32_bf16(fb[3], Sb[3], O, 0, 0, 0);
              O = __builtin_amdgcn_mfma_f32_16x16x32_bf16(fb[4], vb[0], O, 0, 0, 0);
              O = __builtin_amdgcn_mfma_f32_16x16x32_bf16(fb[5], vb[1], O, 0, 0, 0);
              for (int r = 0; r < 4; ++r) obuf[(16 * 3 + 4 * q + r) * 132 + dvc] = O[r]; }
        __builtin_amdgcn_sched_barrier(0);
        fb[0] = *(const LAS bf16x8*)(kl + (16 * 2 + fr) * 144 + 64 * 0 + 16 * q); fb[1] = *(const LAS bf16x8*)(kl + (16 * 2 + fr) * 144 + 64 * 1 + 16 * q); fb[2] = *(const LAS bf16x8*)(kl + (16 * 3 + fr) * 144 + 64 * 0 + 16 * q); fb[3] = *(const LAS bf16x8*)(kl + (16 * 3 + fr) * 144 + 64 * 1 + 16 * q);
        __builtin_amdgcn_sched_barrier(0);
            { f32x4 a0 = S[0] * gl; a0 = __builtin_amdgcn_mfma_f32_16x16x32_bf16(fa[0], vb[0], a0, 0, 0, 0); a0 = __builtin_amdgcn_mfma_f32_16x16x32_bf16(fa[1], vb[1], a0, 0, 0, 0); S[0] = a0; f32x4 a1 = S[1] * gl; a1 = __builtin_amdgcn_mfma_f32_16x16x32_bf16(fa[2], vb[0], a1, 0, 0, 0); a1 = __builtin_amdgcn_mfma_f32_16x16x32_bf16(fa[3], vb[1], a1, 0, 0, 0); S[1] = a1; }
        __builtin_amdgcn_sched_barrier(0);
        fa[0] = *(const LAS bf16x8*)(kl + (16 * 4 + fr) * 144 + 64 * 0 + 16 * q); fa[1] = *(const LAS bf16x8*)(kl + (16 * 4 + fr) * 144 + 64 * 1 + 16 * q); fa[2] = *(const LAS bf16x8*)(kl + (16 * 5 + fr) * 144 + 64 * 0 + 16 * q); fa[3] = *(const LAS bf16x8*)(kl + (16 * 5 + fr) * 144 + 64 * 1 + 16 * q);
        __builtin_amdgcn_sched_barrier(0);
            { f32x4 a0 = S[2] * gl; a0 = __builtin_amdgcn_mfma_f32_16x16x32_bf16(fb[0], vb[0], a0, 0, 0, 0); a0 = __builtin_amdgcn_mfma_f32_16x16x32_bf16(fb[1], vb[1], a0, 0, 0, 0); S[2] = a0; f32x4 a1 = S[3] * gl; a1 = __builtin_amdgcn_mfma_f32_16x16x32_bf16(fb[2], vb[0], a1, 0, 0, 0); a1 = __builtin_amdgcn_mfma_f32_16x16x32_bf16(fb[3], vb[1], a1, 0, 0, 0); S[3] = a1; }
        __builtin_amdgcn_sched_barrier(0);
        fb[0] = *(const LAS bf16x8*)(kl + (16 * 6 + fr) * 144 + 64 * 0 + 16 * q); fb[1] = *(const LAS bf16x8*)(kl + (16 * 6 + fr) * 144 + 64 * 1 + 16 * q); fb[2] = *(const LAS bf16x8*)(kl + (16 * 7 + fr) * 144 + 64 * 0 + 16 * q); fb[3] = *(const LAS bf16x8*)(kl + (16 * 7 + fr) * 144 + 64 * 1 + 16 * q);
        __builtin_amdgcn_sched_barrier(0);
            { f32x4 a0 = S[4] * gl; a0 = __builtin_amdgcn_mfma_f32_16x16x32_bf16(fa[0], vb[0], a0, 0, 0, 0); a0 = __builtin_amdgcn_mfma_f32_16x16x32_bf16(fa[1], vb[1], a0, 0, 0, 0); S[4] = a0; f32x4 a1 = S[5] * gl; a1 = __builtin_amdgcn_mfma_f32_16x16x32_bf16(fa[2], vb[0], a1, 0, 0, 0); a1 = __builtin_amdgcn_mfma_f32_16x16x32_bf16(fa[3], vb[1], a1, 0, 0, 0); S[5] = a1; }
        __builtin_amdgcn_sched_barrier(0);
        __builtin_amdgcn_sched_barrier(0);
            { f32x4 a0 = S[6] * gl; a0 = __builtin_amdgcn_mfma_f32_16x16x32_bf16(fb[0], vb[0], a0, 0, 0, 0); a0 = __builtin_amdgcn_mfma_f32_16x16x32_bf16(fb[1], vb[1], a0, 0, 0, 0); S[6] = a0; f32x4 a1 = S[7] * gl; a1 = __builtin_amdgcn_mfma_f32_16x16x32_bf16(fb[2], vb[0], a1, 0, 0, 0); a1 = __builtin_amdgcn_mfma_f32_16x16x32_bf16(fb[3], vb[1], a1, 0, 0, 0); S[7] = a1; }
        __builtin_amdgcn_sched_barrier(0);
        __syncthreads();
        if (n + 1 < 32) DN_STORE();
#pragma unroll
        for (int m = 0; m < 4; ++m) uu[m] = un[m];
        gl = gln;
        {
            const int row = b * SEQ + n * 64 + ft;
            f32x4 o4[4]; float ss = 0.f;
#pragma unroll
            for (int k = 0; k < 4; ++k) { o4[k] = *(const LAS f32x4*)(obuf + ft * 132 + fc + 4 * k); ss += (o4[k][0] * o4[k][0] + o4[k][1] * o4[k][1]) + (o4[k][2] * o4[k][2] + o4[k][3] * o4[k][3]); }
            ss += __shfl_xor(ss, 1); ss += __shfl_xor(ss, 2); ss += __shfl_xor(ss, 4);
            const float rs = rsqrtf(ss * (1.f / 128.f) + 1e-6f);
            float z[16]; { float z0[8], z1[8]; unpack8(zr0, z0); unpack8(zr1, z1);
#pragma unroll
                for (int e = 0; e < 8; ++e) { z[e] = z0[e]; z[8 + e] = z1[e]; } }
            float o[16];
#pragma unroll
            for (int e = 0; e < 16; ++e) o[e] = o4[e >> 2][e & 3] * rs * nw[e >> 2][e & 3] * siluf_(z[e]);
            u32x4 w0, w1; w0.x = pk2(o[0], o[1]); w0.y = pk2(o[2], o[3]); w0.z = pk2(o[4], o[5]); w0.w = pk2(o[6], o[7]); w1.x = pk2(o[8], o[9]); w1.y = pk2(o[10], o[11]); w1.z = pk2(o[12], o[13]); w1.w = pk2(o[14], o[15]);
            *(u32x4*)(c.OAB + (size_t)row * D + h * 128 + fc) = w0; *(u32x4*)(c.OAB + (size_t)row * D + h * 128 + fc + 8) = w1;
        }
        __syncthreads();
    }
#undef DN_LOAD
#undef DN_STORE
    float* So = p.out + O_PDN + (size_t)((l * NBATCH + b) * 4 + h) * 16384;
#pragma unroll
    for (int i = 0; i < 8; ++i)
#pragma unroll
        for (int r = 0; r < 4; ++r) So[(size_t)(16 * i + 4 * q + r) * 128 + dvc] = S[i][r];
    __syncthreads();
}

DEV void lru_items(const Ctx& c, int l, int first, int stride, int total, int mode, LAS unsigned char* lds) {
    if (first >= total) return;
    const Params& p = *c.p;
    const int blk = first & 3, tid = c.tid, lane = c.lane;
    LAS float* xc = (LAS float*)lds;
    const int w = c.wave, fr = lane & 15, q = lane >> 4, d = 16 * w + fr, ch = blk * 128 + d;
    bf16x8 ba_[4], bx_[4];
    {
        const bf16_t* waT = (const bf16_t*)(wbuf(c, l) + WO_LWA) + (size_t)(blk * 128 + d) * 128 + 8 * q;
        const bf16_t* wxT = (const bf16_t*)(wbuf(c, l) + WO_LWX) + (size_t)(blk * 128 + d) * 128 + 8 * q;
#pragma unroll
        for (int s = 0; s < 4; ++s) { ba_[s] = *(const bf16x8*)(waT + 32 * s); bx_[s] = *(const bf16x8*)(wxT + 32 * s); }
    }
    const float bias_a = p.in[I_LBA][l * 512 + ch], bias_x = p.in[I_LBX][l * 512 + ch];
    const float spl = softplus_(-p.in[I_LAM][l * 512 + ch]);
    const int cr = tid >> 3, c0 = (tid & 7) * 16;
    u32x4 pre[2][4];
#define LRU_PREF(item) do { const int _row = ((item) >> 2) * 64 + cr; _Pragma("unroll") for (int hf = 0; hf < 2; ++hf) _Pragma("unroll") for (int j = 0; j < 4; ++j) { \
        const int _rr = _row - 3 + j; pre[hf][j] = *(const u32x4*)(c.PROJ + (size_t)(_rr < 0 ? 0 : _rr) * NPROJ + C_LX + blk * 128 + c0 + hf * 8); } } while (0)
    LRU_PREF(first);
    for (int item = first; item < total; item += stride) {
        const int rt = item >> 2, row0 = rt * 64;
        {
            const int row = row0 + cr;
            int pos, sb = 0; const float* hist = nullptr;
            if (row < MP) pos = row & (SEQ - 1); else { sb = (row - MP) >> 2; pos = (row - MP) & 3; hist = p.in[I_SLC] + (size_t)(l * SBATCH + sb) * 3 * 512; }
#pragma unroll
            for (int hf = 0; hf < 2; ++hf) {
                const int cc = blk * 128 + c0 + hf * 8;
                float a[8], own[8];
                { const f32x4 b0 = *(const f32x4*)(p.in[I_LCB] + l * 512 + cc), b1 = *(const f32x4*)(p.in[I_LCB] + l * 512 + cc + 4);
                  a[0] = b0[0]; a[1] = b0[1]; a[2] = b0[2]; a[3] = b0[3]; a[4] = b1[0]; a[5] = b1[1]; a[6] = b1[2]; a[7] = b1[3]; }
#pragma unroll
                for (int j = 0; j < 4; ++j) {
                    float v[8];
                    const int sp = pos - 3 + j;
                    unpack8(pre[hf][j], v);
                    if (sp < 0) {
                        if (hist) { const f32x4 h0 = *(const f32x4*)(hist + (size_t)(pos + j) * 512 + cc), h1 = *(const f32x4*)(hist + (size_t)(pos + j) * 512 + cc + 4);
                            v[0] = h0[0]; v[1] = h0[1]; v[2] = h0[2]; v[3] = h0[3]; v[4] = h1[0]; v[5] = h1[1]; v[6] = h1[2]; v[7] = h1[3]; }
                        else {
#pragma unroll
                            for (int e = 0; e < 8; ++e) v[e] = 0.f; }
                    }
                    const float* cw = p.in[I_LCW] + (size_t)(l * 4 + j) * 512 + cc;
                    const f32x4 w0 = *(const f32x4*)cw, w1 = *(const f32x4*)(cw + 4);
#pragma unroll
                    for (int e = 0; e < 4; ++e) { a[e] += v[e] * w0[e]; a[e + 4] += v[e + 4] * w1[e]; }
                    if (j == 3) {
#pragma unroll
                        for (int e = 0; e < 8; ++e) own[e] = v[e]; }
                }
                *(LAS f32x4*)(xc + cr * 132 + c0 + hf * 8) = (f32x4){a[0], a[1], a[2], a[3]}; *(LAS f32x4*)(xc + cr * 132 + c0 + hf * 8 + 4) = (f32x4){a[4], a[5], a[6], a[7]};
                if (mode == 1) {
                    float* dst = nullptr;
                    if (row < MP) { if (pos >= SEQ - 3) dst = p.out + O_PLC + ((size_t)(l * NBATCH + (row >> 11)) * 3 + (pos - (SEQ - 3))) * 512 + cc; }
                    else if (pos >= 1) dst = p.out + O_SLC + ((size_t)(l * SBATCH + sb) * 3 + (pos - 1)) * 512 + cc;
                    if (dst) { *(f32x4*)dst = (f32x4){own[0], own[1], own[2], own[3]}; *(f32x4*)(dst + 4) = (f32x4){own[4], own[5], own[6], own[7]}; }
                }
            }
        }
        if (item + stride < total) LRU_PREF(item + stride);
        unsigned short yraw[4][4];
        float ca[8], chh[8];
        const int bq = rt >> 5, ci = rt & 31;
        if (mode == 1) {
#pragma unroll
            for (int m = 0; m < 4; ++m)
#pragma unroll
                for (int r = 0; r < 4; ++r) yraw[m][r] = c.PROJ[(size_t)(row0 + 16 * m + 4 * q + r) * NPROJ + C_LY + ch];
            if (row0 < MP) {
#pragma unroll
                for (int jj = 0; jj < 8; ++jj) { const size_t o = (size_t)((bq * 32 + 8 * q + jj) * 512 + ch); ca[jj] = c.CSA[o]; chh[jj] = c.CSH[o]; }
            }
        }
        __syncthreads();
        float av[4][4], bv[4][4];
#pragma unroll
        for (int m = 0; m < 4; ++m) {
            f32x4 aa = {0.f, 0.f, 0.f, 0.f}, ax = {0.f, 0.f, 0.f, 0.f};
#pragma unroll
            for (int s = 0; s < 4; ++s) {
                const LAS float* src = xc + (16 * m + fr) * 132 + 32 * s + 8 * q;
                const f32x4 x0 = *(const LAS f32x4*)src, x1 = *(const LAS f32x4*)(src + 4);
                union { u32x4 u; bf16x8 b; } af; af.u.x = pk2(x0[0], x0[1]); af.u.y = pk2(x0[2], x0[3]); af.u.z = pk2(x1[0], x1[1]); af.u.w = pk2(x1[2], x1[3]);
                aa = __builtin_amdgcn_mfma_f32_16x16x32_bf16(af.b, ba_[s], aa, 0, 0, 0);
                ax = __builtin_amdgcn_mfma_f32_16x16x32_bf16(af.b, bx_[s], ax, 0, 0, 0);
            }
#pragma unroll
            for (int r = 0; r < 4; ++r) {
                const int rowl = 16 * m + 4 * q + r, row = row0 + rowl;
                const float rr = sigm(aa[r] + bias_a), ii = sigm(ax[r] + bias_x);
                const float la = -8.f * rr * spl;
                float mult = sqrtf(neg_expm1(2.f * la));
                if (row < MP && (row & (SEQ - 1)) == 0) mult = 1.f;
                av[m][r] = __expf(la); bv[m][r] = mult * ii * xc[rowl * 132 + d];
            }
        }
        if (row0 < MP) {
            float carry = 0.f;
            if (mode == 1) {
                float Aq = 1.f, Hq = 0.f;
#pragma unroll
                for (int jj = 0; jj < 8; ++jj) { const bool on = (8 * q + jj) < ci; Hq = on ? ca[jj] * Hq + chh[jj] : Hq; Aq = on ? Aq * ca[jj] : Aq; }
#pragma unroll
                for (int qq = 0; qq < 4; ++qq) { const float A_ = __shfl(Aq, fr + 16 * qq), H_ = __shfl(Hq, fr + 16 * qq); carry = A_ * carry + H_; }
            }
            float tA = 1.f, tH = 0.f;
#pragma unroll
            for (int m = 0; m < 4; ++m) {
                float As = av[m][0], Bs = bv[m][0];
#pragma unroll
                for (int r = 1; r < 4; ++r) { Bs = av[m][r] * Bs + bv[m][r]; As *= av[m][r]; }
                float hs = carry, hn = carry;
#pragma unroll
                for (int qq = 0; qq < 4; ++qq) { const float Aq = __shfl(As, fr + 16 * qq), Bq = __shfl(Bs, fr + 16 * qq);
                    if (qq < q) hs = Aq * hs + Bq;
                    hn = Aq * hn + Bq;
                    tH = Aq * tH + Bq; tA *= Aq; }
                if (mode == 1) {
                    float hcur = hs;
#pragma unroll
                    for (int r = 0; r < 4; ++r) { const int row = row0 + 16 * m + 4 * q + r;
                        hcur = av[m][r] * hcur + bv[m][r];
                        c.OAB[(size_t)row * D + 512 + ch] = (bf16_t)f2bf(hcur * gelu_t(bf2f(yraw[m][r]))); }
                    if (ci == 31 && m == 3 && q == 3) p.out[O_PL + (size_t)(l * NBATCH + bq) * 512 + ch] = hcur;
                }
                carry = hn;
            }
            if (mode == 0 && q == 0) { const size_t o = (size_t)(rt * 512 + ch); c.CSA[o] = tA; c.CSH[o] = tH; }
        } else if (mode == 1) {
#pragma unroll
            for (int m = 0; m < 4; ++m) { const int sb = (rt - MP / 64) * 16 + 4 * m + q;
                float hcur = p.in[I_SL][(size_t)(l * SBATCH + sb) * 512 + ch];
#pragma unroll
                for (int r = 0; r < 4; ++r) { const int row = row0 + 16 * m + 4 * q + r;
                    hcur = av[m][r] * hcur + bv[m][r];
                    c.OAB[(size_t)row * D + 512 + ch] = (bf16_t)f2bf(hcur * gelu_t(bf2f(yraw[m][r]))); }
                p.out[O_SL + (size_t)(l * SBATCH + sb) * 512 + ch] = hcur; }
        }
        __syncthreads();
    }
#undef LRU_PREF
}

DEV void dn_scan_item(const Ctx& c, int l, int row0, int ntok, int h, const float* S0, float* Sout, LAS unsigned char* lds) {
    const Params& p = *c.p;
    const int tid = c.tid, kg = tid >> 7, v = tid & 127, lane = c.lane, wave = c.wave;
    LAS float* qk = (LAS float*)lds;
    LAS float* rpart = qk + 512;
    LAS float* opart = rpart + 512;
    LAS float* ssb = opart + 512;
    float S[32];
#pragma unroll
    for (int i = 0; i < 32; ++i) S[i] = S0 ? S0[(size_t)(32 * kg + i) * 128 + v] : 0.f;
    const float nw = p.in[I_DNW][l * 128 + v];
    const int qcol = (tid < 128) ? (h * 128 + tid) : (512 + h * 128 + (tid - 128));
    float pre = 0.f;
    if (tid < 256) { qk[tid] = bf2f(c.QKVN[(size_t)(row0 - MP) * 1536 + qcol]); if (ntok > 1) pre = bf2f(c.QKVN[(size_t)(row0 + 1 - MP) * 1536 + qcol]); }
    __syncthreads();
    float o_prev = 0.f;
    for (int t = 0; t < ntok; ++t) {
        const int row = row0 + t;
        const LAS float* cur = qk + (t & 1) * 256;
        const float vv = bf2f(c.QKVN[(size_t)(row - MP) * 1536 + 1024 + h * 128 + v]);
        const float g = c.GB[(size_t)(row - MP) * 8 + h], beta = c.GB[(size_t)(row - MP) * 8 + 4 + h];
        float r0 = 0.f, r1 = 0.f, r2 = 0.f, r3 = 0.f;
#pragma unroll
        for (int i = 0; i < 32; i += 4) { const f32x4 kk = *(const LAS f32x4*)(cur + 128 + 32 * kg + i);
            r0 += kk[0] * S[i]; r1 += kk[1] * S[i + 1]; r2 += kk[2] * S[i + 2]; r3 += kk[3] * S[i + 3]; }
        rpart[kg * 128 + v] = (r0 + r1) + (r2 + r3);
        if (tid < 256) { qk[((t + 1) & 1) * 256 + tid] = pre; if (t + 2 < ntok) pre = bf2f(c.QKVN[(size_t)(row + 2 - MP) * 1536 + qcol]); }
        __syncthreads();
        const float r = (rpart[v] + rpart[128 + v]) + (rpart[256 + v] + rpart[384 + v]);
        const float eg = __expf(g), dd = beta * (vv - eg * r);
        float o0 = 0.f, o1 = 0.f, o2 = 0.f, o3 = 0.f;
#pragma unroll
        for (int i = 0; i < 32; i += 4) { const f32x4 kk = *(const LAS f32x4*)(cur + 128 + 32 * kg + i), qq = *(const LAS f32x4*)(cur + 32 * kg + i);
            S[i] = eg * S[i] + kk[0] * dd; S[i + 1] = eg * S[i + 1] + kk[1] * dd; S[i + 2] = eg * S[i + 2] + kk[2] * dd; S[i + 3] = eg * S[i + 3] + kk[3] * dd;
            o0 += qq[0] * S[i]; o1 += qq[1] * S[i + 1]; o2 += qq[2] * S[i + 2]; o3 += qq[3] * S[i + 3]; }
        opart[kg * 128 + v] = (o0 + o1) + (o2 + o3);
        if (tid < 128 && t > 0) {
            const float ss = ssb[((t - 1) & 1) * 2] + ssb[((t - 1) & 1) * 2 + 1];
            const float rs = rsqrtf(ss * (1.f / 128.f) + 1e-6f);
            const float z = bf2f(c.PROJ[(size_t)(row - 1) * NPROJ + C_Z + h * 128 + v]);
            c.OAB[(size_t)(row - 1) * D + h * 128 + v] = (bf16_t)f2bf(o_prev * rs * nw * siluf_(z));
        }
        __syncthreads();
        if (tid < 128) { o_prev = (opart[v] + opart[128 + v]) + (opart[256 + v] + opart[384 + v]); const float s2 = wave_sum(o_prev * o_prev); if (lane == 0) ssb[(t & 1) * 2 + wave] = s2; }
    }
    __syncthreads();
    if (tid < 128) {
        const int t = ntok - 1, row = row0 + t;
        const float ss = ssb[(t & 1) * 2] + ssb[(t & 1) * 2 + 1];
        const float rs = rsqrtf(ss * (1.f / 128.f) + 1e-6f);
        const float z = bf2f(c.PROJ[(size_t)row * NPROJ + C_Z + h * 128 + v]);
        c.OAB[(size_t)row * D + h * 128 + v] = (bf16_t)f2bf(o_prev * rs * nw * siluf_(z));
    }
#pragma unroll
    for (int i = 0; i < 32; ++i) Sout[(size_t)(32 * kg + i) * 128 + v] = S[i];
    __syncthreads();
}

DEV void ffn_fix(const Ctx& c, int l) {
    const Params& p = *c.p;
    const bf16_t* RAWG = (const bf16_t*)(c.ws + WS_RAWG); const bf16_t* RAWU = (const bf16_t*)(c.ws + WS_RAWU);
    const int GT = c.G * 512;
    for (int idx = c.bid * 512 + c.tid; idx < (MP / 64) * 2 * 384; idx += GT) {
        const int cg_ = idx % 384, rr = (idx / 384) & 1, grp = idx / 768, f0 = cg_ * 8, row = grp * 64 + rr;
        const bool seqstart = (grp & 31) == 0;
        float w0[8], w1[8], w2[8], g0[8], g1[8], g2[8], u[8], o[8];
        { const float* fw = p.in[I_FCW] + (size_t)l * 3 * DFF + f0;
#pragma unroll
          for (int e = 0; e < 8; ++e) { w0[e] = fw[e]; w1[e] = fw[DFF + e]; w2[e] = fw[2 * DFF + e]; g1[e] = 0.f; g2[e] = 0.f; } }
        unpack8(*(const u32x4*)(RAWG + (size_t)(grp * 4 + rr) * DFF + f0), g0);
        unpack8(*(const u32x4*)(RAWU + (size_t)(grp * 2 + rr) * DFF + f0), u);
        if (rr) { unpack8(*(const u32x4*)(RAWG + (size_t)(grp * 4) * DFF + f0), g1); if (!seqstart) unpack8(*(const u32x4*)(RAWG + (size_t)((grp - 1) * 4 + 3) * DFF + f0), g2); }
        else if (!seqstart) { unpack8(*(const u32x4*)(RAWG + (size_t)((grp - 1) * 4 + 3) * DFF + f0), g1); unpack8(*(const u32x4*)(RAWG + (size_t)((grp - 1) * 4 + 2) * DFF + f0), g2); }
#pragma unroll
        for (int e = 0; e < 8; ++e) o[e] = gelu_t(w0[e] * g2[e] + w1[e] * g1[e] + w2[e] * g0[e]) * u[e];
        *(u32x4*)(c.HB + (size_t)row * DFF + f0) = pack8(o);
        if ((grp & 31) == 31) {
            float gl_[8]; unpack8(*(const u32x4*)(RAWG + (size_t)(grp * 4 + 2 + rr) * DFF + f0), gl_);
            float* dst = p.out + O_PFC + ((size_t)(l * NBATCH + (grp >> 5)) * 2 + rr) * DFF + f0;
            *(f32x4*)dst = (f32x4){gl_[0], gl_[1], gl_[2], gl_[3]}; *(f32x4*)(dst + 4) = (f32x4){gl_[4], gl_[5], gl_[6], gl_[7]};
        }
    }
}

DEV void sample_fixup(const Ctx& c) {
    const int gw = c.bid * 8 + c.wave, NGW = c.G * 8;
    const float* Z = (const float*)(c.ws + WS_Z);
    for (int r = gw; r < MS; r += NGW) {
        const int row = MP + r; float ss = 0.f;
#pragma unroll
        for (int j = 0; j < 4; ++j) {
            const size_t o = (size_t)r * D + j * 256 + c.lane * 4;
            const f32x4 z = (*(const f32x4*)(Z + o) + *(const f32x4*)(Z + (size_t)MS * D + o)) + *(const f32x4*)(Z + (size_t)2 * MS * D + o);
            const u32x2 xi = *(const u32x2*)(c.XB + (size_t)row * D + j * 256 + c.lane * 4);
            const float x0 = __uint_as_float(xi.x << 16) + z[0], x1 = __uint_as_float(xi.x & 0xffff0000u) + z[1], x2 = __uint_as_float(xi.y << 16) + z[2], x3 = __uint_as_float(xi.y & 0xffff0000u) + z[3];
            u32x2 w; w.x = pk2(x0, x1); w.y = pk2(x2, x3); *(u32x2*)(c.XB + (size_t)row * D + j * 256 + c.lane * 4) = w;
            const float r0 = __uint_as_float(w.x << 16), r1 = __uint_as_float(w.x & 0xffff0000u), r2 = __uint_as_float(w.y << 16), r3 = __uint_as_float(w.y & 0xffff0000u);
            ss += (r0 * r0 + r1 * r1) + (r2 * r2 + r3 * r3);
        }
        ss = wave_sum(ss);
        if (c.lane < NSLOT) c.SSQ[(size_t)row * NSLOT + c.lane] = (c.lane == 0) ? ss : 0.f;
    }
}

DEV void final_norm(const Ctx& c) {
    const int gw = c.bid * 8 + c.wave, NGW = c.G * 8;
    const float* fw = c.p->in[I_FNW];
    for (int row = gw; row < M; row += NGW) {
        float s = 0.f;
#pragma unroll
        for (int k = 0; k < NSLOT; ++k) s += c.SSQ[(size_t)row * NSLOT + k];
        const float rs = rsqrtf(s * (1.f / 1024.f) + 1e-6f);
#pragma unroll
        for (int j = 0; j < 4; ++j) { const u32x2 xi = *(const u32x2*)(c.XB + (size_t)row * D + j * 256 + c.lane * 4); const f32x4 w = *(const f32x4*)(fw + j * 256 + c.lane * 4);
            const f32x4 v = {__uint_as_float(xi.x << 16), __uint_as_float(xi.x & 0xffff0000u), __uint_as_float(xi.y << 16), __uint_as_float(xi.y & 0xffff0000u)};
            *(f32x4*)(c.p->out + (size_t)row * D + j * 256 + c.lane * 4) = v * rs * w; }
    }
}

__global__ void __launch_bounds__(512, 2) mega(Params prm) {
    extern __shared__ __attribute__((aligned(16))) unsigned char lds_raw[];
    LAS unsigned char* lds = (LAS unsigned char*)lds_raw;
    cg::grid_group grid = cg::this_grid();
    volatile LAS unsigned* bst = (volatile LAS unsigned*)(lds + 147200);
    if (threadIdx.x < 2) bst[threadIdx.x] = 0u;
    __syncthreads();
    const XcdBarrier xbar = xcd_barrier_post((unsigned*)prm.ws, bst);

    { const Ctx c = mk(prm); convert_layer(c, 0, c.bid * 8 + c.wave, c.G * 8, lds); x_prologue(c); }
    grid.sync();

    for (int l = 0; l < DEPTH; ++l) {
        { const Ctx c = mk(prm); unsigned char* wb = wbuf(c, l);
          pg8::Gemm g{c.XB, (const bf16_t*)(wb + WO_WIN), D, D, D}; pg8::StaticOrder S; S.init(M, NPROJ, c.G, c.bid);
          pg8::EpiScaleBf16 E{c.PROJ, NPROJ, c.SSQ};
          pg8::gemm_phase<pg8::EpiScaleBf16, pg8::StaticOrder, 0>(lds, g, S, E); }
        xcd_barrier(xbar);
        { const Ctx c = mk(prm); for (int it = c.bid; it < NBATCH * 32 * 4; it += c.G) dn_chunk_prep(c, l, it, lds); }
        { const Ctx c = mk(prm); lru_items(c, l, c.bid, c.G, (MP / 64) * 4, 0, lds); }
        { const Ctx c = mk(prm); dn_prep_rows(c, l); }
        xcd_barrier(xbar);
        { const Ctx c = mk(prm);
        if (c.bid < 32) {
            dn_chunk_scan(c, l, c.bid >> 2, c.bid & 3, lds);
        } else {
            const int nb = c.G - 32, ob = c.bid - 32;
            lru_items(c, l, ob, nb, (M / 64) * 4, 1, lds);
            for (int it = ob; it < SBATCH * 4; it += nb) { const int sb = it >> 2, h = it & 3; const size_t so = (size_t)((l * SBATCH + sb) * 4 + h) * 16384;
                dn_scan_item(c, l, MP + sb * 4, 4, h, prm.in[I_SDN] + so, prm.out + O_SDN + so, lds); }
        } }
        xcd_barrier(xbar);
        { const Ctx c = mk(prm); unsigned char* wb = wbuf(c, l);
          pg8::Gemm g{c.OAB, (const bf16_t*)(wb + WO_WAB), D, D, 512}; pg8::TwoHalfOrder S; S.init(M, D, c.G, c.bid);
          pg8::EpiMerge E{c.MERGED, c.PROJ};
          pg8::gemm_phase<pg8::EpiMerge, pg8::TwoHalfOrder, 1>(lds, g, S, E); }
        xcd_barrier(xbar);
        { const Ctx c = mk(prm); unsigned char* wb = wbuf(c, l);
          pg8::Gemm g{c.MERGED, (const bf16_t*)(wb + WO_WO), D, D, D}; pg8::StaticOrder S; S.init(M, D, c.G, c.bid);
          pg8::EpiResid E{c.XB, c.SSQ};
          pg8::gemm_phase<pg8::EpiResid, pg8::StaticOrder, 0>(lds, g, S, E); }
        xcd_barrier(xbar);
        { const Ctx c = mk(prm); unsigned char* wb = wbuf(c, l);
          pg8::Gemm g{c.XB, (const bf16_t*)(wb + WO_WFF), D, D, D}; pg8::StaticOrder S; S.init(M, 2 * DFF, c.G, c.bid);
          pg8::EpiAct E{c.HB, c.SSQ, (bf16_t*)(c.ws + WS_RAWG), (bf16_t*)(c.ws + WS_RAWU), prm.in[I_FCW] + (size_t)l * 3 * DFF, prm.in[I_SFC] + (size_t)l * SBATCH * 2 * DFF, prm.out + O_SFC + (size_t)l * SBATCH * 2 * DFF};
          pg8::gemm_phase<pg8::EpiAct, pg8::StaticOrder, 0>(lds, g, S, E); }
        xcd_barrier(xbar);
        { const Ctx c = mk(prm); ffn_fix(c, l); }
        xcd_barrier(xbar);
        { const Ctx c = mk(prm); unsigned char* wb = wbuf(c, l);
          pg8::Gemm g{c.HB, (const bf16_t*)(wb + WO_WDN), DFF, DFF, DFF}; pg8::StaticOrder S; S.init(MP, D, c.G, c.bid);
          pg8::EpiResid E{c.XB, c.SSQ};
          pg8::gemm_phase<pg8::EpiResid, pg8::StaticOrder, 0>(lds, g, S, E); }
        { const Ctx c = mk(prm); unsigned char* wb = wbuf(c, l);
          pg8::Gemm g{c.HB, (const bf16_t*)(wb + WO_WDN), DFF, DFF, 1024}; pg8::SampleSplitOrder S{c.G, c.bid};
          pg8::EpiPartial E{(float*)(c.ws + WS_Z)};
          pg8::gemm_phase<pg8::EpiPartial, pg8::SampleSplitOrder, 2>(lds, g, S, E);
          if (l + 1 < DEPTH && c.bid >= 24) convert_layer(c, l + 1, (c.bid - 24) * 8 + c.wave, (c.G - 24) * 8, lds); }
        xcd_barrier(xbar);
        { const Ctx c = mk(prm); sample_fixup(c); }
        xcd_barrier(xbar);
    }
    { const Ctx c = mk(prm); final_norm(c); }
}

extern "C" void kernel_launch(void* const* d_in, const int* in_sizes, int n_in, void* d_out, int out_size, void* d_ws, size_t ws_size, hipStream_t stream) {
    static int grid = 0;
    if (grid == 0) {
        if (n_in != 28 || (size_t)out_size != O_END || ws_size < WS_END) { fprintf(stderr, "kernel_launch: unexpected shapes n_in %d out %d ws %zu\n", n_in, out_size, ws_size); grid = -1; return; }
        int dev = 0, cus = 0, per_cu = 0;
        (void)hipGetDevice(&dev);
        (void)hipDeviceGetAttribute(&cus, hipDeviceAttributeMultiprocessorCount, dev);
        (void)hipFuncSetAttribute((const void*)mega, hipFuncAttributeMaxDynamicSharedMemorySize, LDS_BYTES);
        (void)hipOccupancyMaxActiveBlocksPerMultiprocessor(&per_cu, (const void*)mega, 512, LDS_BYTES);
        fprintf(stderr, "kernel_launch: cus %d per_cu %d ws %zu\n", cus, per_cu, ws_size);
        grid = cus;
    }
    if (grid < 0) return;
    (void)hipMemsetAsync(d_ws, 0, 16384, stream);
    Params p{};
    for (int i = 0; i < 28; ++i) p.in[i] = (const float*)d_in[i];
    p.out = (float*)d_out; p.ws = (unsigned char*)d_ws;
    void* args[] = {&p};
    hipError_t e = hipLaunchCooperativeKernel((const void*)mega, dim3(grid), dim3(512), args, LDS_BYTES, stream);
    if (e != hipSuccess) fprintf(stderr, "kernel_launch: cooperative launch failed: %s\n", hipGetErrorString(e));
}
```
